# Optimizing an MI355X kernel written in HIP

```python
import math
import jax, jax.numpy as jnp
from jax import lax
import numpy as np

D_MODEL = 2048
BATCH = 2
SEQ = 8192
DEPTH = 2

N_MIXERS = 2
N_S5 = (DEPTH + 1) // 2
N_DSA = DEPTH // 2
S5_GROUP = 16
S5_GROUPS = D_MODEL // S5_GROUP
S5_STATE = 64
DT_MIN = 0.001
DT_MAX = 0.1
N_HEADS = 16
HEAD_DIM = D_MODEL // N_HEADS
IDX_HEADS = 16
IDX_DIM = 64
TOPK_MAX = 256
Q_BLOCK = 128
ROPE_THETA = 10000.0
DSA_IN = 3 * D_MODEL + IDX_HEADS * IDX_DIM + IDX_HEADS + IDX_DIM
D_FF = ((8 * D_MODEL // 3 + 255) // 256) * 256
ALPHA = (2.0 * DEPTH) ** 0.25
BETA = (8.0 * DEPTH) ** -0.25
LN_EPS = 1e-5

kernel_name = "hybrid_s5_dsa_deepnorm_adaln"


def layer_norm(x, g, b):
    xf = x.astype(jnp.float32)
    mu = jnp.mean(xf, axis=-1, keepdims=True)
    var = jnp.mean(jnp.square(xf - mu), axis=-1, keepdims=True)
    y = (xf - mu) * lax.rsqrt(var + LN_EPS)
    return (y * g.astype(jnp.float32) + b.astype(jnp.float32)).astype(x.dtype)


def rope_tables(positions, dim):
    inv = 1.0 / (ROPE_THETA ** (jnp.arange(0, dim, 2, dtype=jnp.float32) / dim))
    ang = positions.astype(jnp.float32)[..., None] * inv
    return jnp.cos(ang), jnp.sin(ang)


def apply_rope(x, cos, sin):
    half = x.shape[-1] // 2
    xf = x.astype(jnp.float32)
    x1, x2 = xf[..., :half], xf[..., half:]
    cs, sn = cos[:, :, None, :], sin[:, :, None, :]
    return jnp.concatenate([x1 * cs - x2 * sn, x2 * cs + x1 * sn], axis=-1).astype(x.dtype)


def s5_mixer(h, in_w, a_re, a_im, log_dt, b_re, b_im, c_re, c_im, d_skip, glu_w, glu_b):
    Bsz, L, D = h.shape
    f32 = jnp.float32
    u = h @ in_w
    ug = u.reshape(Bsz, L, S5_GROUPS, S5_GROUP).astype(f32).astype(jnp.complex64)
    lam = lax.complex(a_re.astype(f32), a_im.astype(f32))
    dt = jnp.exp(log_dt.astype(f32))[:, None]
    lam_bar = jnp.exp(lam * dt)
    bmat = lax.complex(b_re.astype(f32), b_im.astype(f32))
    b_bar = ((lam_bar - 1.0) / lam)[..., None] * bmat
    bu = jnp.einsum('gnp,blgp->lbgn', b_bar, ug)
    a_seq = jnp.broadcast_to(lam_bar, (L,) + lam_bar.shape)

    def combine(left, right):
        a_l, b_l = left
        a_r, b_r = right
        return a_r * a_l, a_r[:, None] * b_l + b_r

    _, states = lax.associative_scan(combine, (a_seq, bu), axis=0)
    cmat = lax.complex(c_re.astype(f32), c_im.astype(f32))
    y = jnp.real(jnp.einsum('gpn,lbgn->blgp', cmat, states)).reshape(Bsz, L, D)
    y = y + d_skip.astype(f32) * u.astype(f32)
    g = jax.nn.gelu(y).astype(h.dtype)
    z = g @ glu_w + glu_b
    val, gate = jnp.split(z, 2, axis=-1)
    return val * jax.nn.sigmoid(gate)


def dsa_mixer(h, cos_h, sin_h, cos_i, sin_i, in_w, out_w):
    Bsz, L, D = h.shape
    f32 = jnp.float32
    k_top = min(TOPK_MAX, L // 4)
    proj = h @ in_w
    q, k, v, qi, wi, ki = jnp.split(
        proj, [D, 2 * D, 3 * D, 3 * D + IDX_HEADS * IDX_DIM, 3 * D + IDX_HEADS * IDX_DIM + IDX_HEADS], axis=-1)
    q = apply_rope(q.reshape(Bsz, L, N_HEADS, HEAD_DIM), cos_h, sin_h)
    k = apply_rope(k.reshape(Bsz, L, N_HEADS, HEAD_DIM), cos_h, sin_h)
    v = v.reshape(Bsz, L, N_HEADS, HEAD_DIM)
    qi = apply_rope(qi.reshape(Bsz, L, IDX_HEADS, IDX_DIM), cos_i, sin_i)
    ki = apply_rope(ki[:, :, None, :], cos_i, sin_i)[:, :, 0, :]
    wi = wi * (IDX_HEADS ** -0.5)
    key_pos = jnp.arange(L)
    gather = jax.vmap(lambda arr, idx: arr[idx])

    def block(i):
        start = i * Q_BLOCK
        qb = lax.dynamic_slice_in_dim(q, start, Q_BLOCK, axis=1)
        qib = lax.dynamic_slice_in_dim(qi, start, Q_BLOCK, axis=1)
        wib = lax.dynamic_slice_in_dim(wi, start, Q_BLOCK, axis=1)
        qpos = start + jnp.arange(Q_BLOCK)
        causal = key_pos[None, :] <= qpos[:, None]
        s_idx = jnp.einsum('bqhd,bsd->bqhs', qib, ki, preferred_element_type=f32) * (IDX_DIM ** -0.5)
        score = jnp.einsum('bqh,bqhs->bqs', wib.astype(f32), jax.nn.relu(s_idx))
        score = jnp.where(causal[None], score, -jnp.inf)
        _, sel = lax.top_k(score, k_top)
        valid = sel <= qpos[None, :, None]
        kg = gather(k, sel)
        vg = gather(v, sel)
        logits = jnp.einsum('bqhd,bqkhd->bhqk', qb, kg, preferred_element_type=f32) * (HEAD_DIM ** -0.5)
        logits = jnp.where(valid[:, None], logits, -jnp.inf)
        p = jax.nn.softmax(logits, axis=-1).astype(v.dtype)
        ob = jnp.einsum('bhqk,bqkhd->bqhd', p, vg)
        return ob.reshape(Bsz, Q_BLOCK, D)

    out = lax.map(block, jnp.arange(L // Q_BLOCK))
    out = jnp.transpose(out, (1, 0, 2, 3)).reshape(Bsz, L, D)
    return out @ out_w


def swiglu(h, w_in, w_out):
    g, u = jnp.split(h @ w_in, 2, axis=-1)
    return (jax.nn.silu(g) * u) @ w_out


def setup_inputs(seed: int = 0) -> dict:
    key = jax.random.key(seed)
    ks = jax.random.split(key, 24)
    f32 = jnp.float32
    D = D_MODEL

    def nrm(k, shape, scale):
        return jax.random.normal(k, shape, f32) * scale

    x = nrm(ks[0], (BATCH, SEQ, D), 1.0)
    c = nrm(ks[1], (BATCH, D), 1.0)
    positions = (jax.random.randint(ks[2], (BATCH, 1), 0, 4096) + jnp.arange(SEQ)[None, :]).astype(jnp.int32)
    ada_w = nrm(ks[3], (DEPTH, D, 6 * D), 0.1 * D ** -0.5)
    ada_b = nrm(ks[4], (DEPTH, 6 * D), 0.01)
    ln_g = 1.0 + nrm(ks[5], (DEPTH, 2, D), 0.02)
    ln_b = nrm(ks[6], (DEPTH, 2, D), 0.02)
    s5_in_w = nrm(ks[7], (N_S5, D, D), D ** -0.5)
    n_idx = jnp.arange(S5_STATE, dtype=f32)
    s5_a_re = -0.5 * jnp.exp(nrm(ks[8], (N_S5, S5_GROUPS, S5_STATE), 0.05))
    s5_a_im = math.pi * n_idx + nrm(ks[9], (N_S5, S5_GROUPS, S5_STATE), 0.05)
    s5_log_dt = jax.random.uniform(ks[10], (N_S5, S5_GROUPS), f32, math.log(DT_MIN), math.log(DT_MAX))
    s5_b_re = nrm(ks[11], (N_S5, S5_GROUPS, S5_STATE, S5_GROUP), (2 * S5_GROUP) ** -0.5)
    s5_b_im = nrm(ks[12], (N_S5, S5_GROUPS, S5_STATE, S5_GROUP), (2 * S5_GROUP) ** -0.5)
    s5_c_re = nrm(ks[13], (N_S5, S5_GROUPS, S5_GROUP, S5_STATE), S5_STATE ** -0.5)
    s5_c_im = nrm(ks[14], (N_S5, S5_GROUPS, S5_GROUP, S5_STATE), S5_STATE ** -0.5)
    s5_d = nrm(ks[15], (N_S5, D), 1.0)
    s5_glu_w = nrm(ks[16], (N_S5, D, 2 * D), D ** -0.5)
    s5_glu_w = s5_glu_w.at[:, :, :D].multiply(BETA)
    s5_glu_b = nrm(ks[17], (N_S5, 2 * D), 0.01)
    dsa_in_w = nrm(ks[18], (N_DSA, D, DSA_IN), D ** -0.5)
    dsa_out_w = nrm(ks[19], (N_DSA, D, D), BETA * D ** -0.5)
    ffn_w_in = nrm(ks[20], (DEPTH, D, 2 * D_FF), D ** -0.5)
    ffn_w_out = nrm(ks[21], (DEPTH, D_FF, D), BETA * D_FF ** -0.5)
    return {"x": x, "c": c, "positions": positions, "ada_w": ada_w, "ada_b": ada_b,
            "ln_g": ln_g, "ln_b": ln_b, "s5_in_w": s5_in_w, "s5_a_re": s5_a_re, "s5_a_im": s5_a_im,
            "s5_log_dt": s5_log_dt, "s5_b_re": s5_b_re, "s5_b_im": s5_b_im, "s5_c_re": s5_c_re,
            "s5_c_im": s5_c_im, "s5_d": s5_d, "s5_glu_w": s5_glu_w, "s5_glu_b": s5_glu_b,
            "dsa_in_w": dsa_in_w, "dsa_out_w": dsa_out_w, "ffn_w_in": ffn_w_in, "ffn_w_out": ffn_w_out}


def reference(x, c, positions, ada_w, ada_b, ln_g, ln_b, s5_in_w, s5_a_re, s5_a_im, s5_log_dt,
              s5_b_re, s5_b_im, s5_c_re, s5_c_im, s5_d, s5_glu_w, s5_glu_b, dsa_in_w, dsa_out_w,
              ffn_w_in, ffn_w_out):
    cos_h, sin_h = rope_tables(positions, HEAD_DIM)
    cos_i, sin_i = rope_tables(positions, IDX_DIM)
    c_act = jax.nn.silu(c)
    for i in range(DEPTH):
        mod = c_act @ ada_w[i] + ada_b[i]
        sh1, sc1, g1, sh2, sc2, g2 = [m[:, None, :] for m in jnp.split(mod, 6, axis=-1)]
        h = x * (1.0 + sc1) + sh1
        j = i // N_MIXERS
        if i % N_MIXERS == 0:
            y = s5_mixer(h, s5_in_w[j], s5_a_re[j], s5_a_im[j], s5_log_dt[j], s5_b_re[j], s5_b_im[j],
                         s5_c_re[j], s5_c_im[j], s5_d[j], s5_glu_w[j], s5_glu_b[j])
        else:
            y = dsa_mixer(h, cos_h, sin_h, cos_i, sin_i, dsa_in_w[j], dsa_out_w[j])
        x = layer_norm(ALPHA * x + (1.0 + g1) * y, ln_g[i, 0], ln_b[i, 0])
        h = x * (1.0 + sc2) + sh2
        x = layer_norm(ALPHA * x + (1.0 + g2) * swiglu(h, ffn_w_in[i], ffn_w_out[i]), ln_g[i, 1], ln_b[i, 1])
    return x
```

```cpp
#include <hip/hip_runtime.h>
#include <hip/hip_cooperative_groups.h>
#include <cstdio>
#include <cstdint>
namespace cg = cooperative_groups;

#define LAS __attribute__((address_space(3)))
typedef unsigned short bf16_t;
typedef short bf16x8 __attribute__((ext_vector_type(8)));
typedef float f32x4 __attribute__((ext_vector_type(4)));
typedef float f32x2 __attribute__((ext_vector_type(2)));
typedef float f32x16 __attribute__((ext_vector_type(16)));
typedef unsigned u32x4 __attribute__((ext_vector_type(4)));
typedef unsigned u32x2 __attribute__((ext_vector_type(2)));

constexpr int D = 2048, SEQ = 8192, M = 16384, DFF = 5632, DSA_IN = 7248, DSA_NP = 7424;
constexpr float ALPHA = 1.41421356237309515f, LN_EPS = 1e-5f;
constexpr float QSCALE = 0.08838834764831845f * 1.4426950408889634f;
constexpr int NTHR = 512, NW = 8;
constexpr int LDS_BYTES = 147456;
constexpr int CH_T = 32, NCH = SEQ / CH_T;
constexpr int ESTR = 132;

constexpr size_t MiB = 1u << 20;
constexpr size_t OFF_MOD = 0, OFF_LAMT = 256 * 1024, OFF_CSH = 1 * MiB, OFF_CSI = 9 * MiB, OFF_KM = 13 * MiB, OFF_WE = 15 * MiB, OFF_WP = 31 * MiB;
constexpr size_t OFF_W_S5IN = 47 * MiB, OFF_W_GLU = 55 * MiB, OFF_W_FIN0 = 71 * MiB, OFF_W_FIN1 = 115 * MiB, OFF_W_FOUT0 = 159 * MiB, OFF_W_FOUT1 = 181 * MiB;
constexpr size_t OFF_W_DIN = 203 * MiB, OFF_W_DOUT = 232 * MiB;
constexpr size_t OFF_X = 240 * MiB, OFF_V = 368 * MiB, OFF_HB = 496 * MiB, OFF_ACT = 560 * MiB;
constexpr size_t OFF_UG = 560 * MiB, OFF_G = 624 * MiB;
constexpr size_t OFF_Q = 560 * MiB, OFF_K = 624 * MiB, OFF_VT = 688 * MiB, OFF_KI = 752 * MiB, OFF_WI = 754 * MiB;
constexpr size_t OFF_QI = 368 * MiB, OFF_MASK = 400 * MiB, OFF_SCR = 416 * MiB;
constexpr size_t OFF_O = OFF_HB;
constexpr size_t WS_NEED = 756 * MiB;

struct Params {
    const float *x, *c; const int* pos; const float *ada_w, *ada_b, *ln_g, *ln_b, *s5_in_w, *a_re, *a_im, *log_dt, *b_re, *b_im, *c_re, *c_im, *s5_d,
        *glu_w, *glu_b, *dsa_in_w, *dsa_out_w, *ffn_w_in, *ffn_w_out;
    float* out; unsigned char* ws; int ph_lo, ph_hi;
};

__device__ __forceinline__ unsigned f2bf(float f) { unsigned u = __builtin_bit_cast(unsigned, f); return (u + 0x7fffu + ((u >> 16) & 1u)) >> 16; }
typedef __bf16 bf16x2_t __attribute__((ext_vector_type(2)));
__device__ __forceinline__ unsigned pk2(float lo, float hi) { f32x2 v = {lo, hi}; bf16x2_t b = __builtin_convertvector(v, bf16x2_t); return __builtin_bit_cast(unsigned, b); }
__device__ __forceinline__ float bf2f(unsigned short v) { return __builtin_bit_cast(float, ((unsigned)v) << 16); }
__device__ __forceinline__ float sigmoidf_(float v) { return __builtin_amdgcn_rcpf(1.0f + __expf(-v)); }
__device__ __forceinline__ f32x16 mfma32(bf16x8 a, bf16x8 b, f32x16 c) { return __builtin_amdgcn_mfma_f32_32x32x16_bf16(a, b, c, 0, 0, 0); }
__device__ __forceinline__ int crow(int r, int hi) { return (r & 3) + 8 * (r >> 2) + 4 * hi; }
__device__ __forceinline__ float wave_sum(float v) {
#pragma unroll
    for (int o = 1; o < 64; o <<= 1) v += __shfl_xor(v, o);
    return v;
}
__device__ __forceinline__ void sincos_rev(double rev, float& s, float& c) {
    double fr = rev - floor(rev); float f = (float)fr; s = __builtin_amdgcn_sinf(f); c = __builtin_amdgcn_cosf(f);
}

namespace pg8 {
constexpr int BM = 256, BK = 64, HALF = 128, HTB = HALF * BK * 2, STAGE_BYTES = 8 * HTB, NXCD = 8, WGM = 8;
__host__ __device__ __forceinline__ int lds_byte(int r, int c) { const int st = (r >> 4) * 2 + (c >> 5), rr = r & 15, cc = c & 31, ob = rr * 64 + cc * 2; return st * 1024 + (ob ^ (((ob >> 9) & 1) << 5)); }
__host__ __device__ __forceinline__ void stage_rc(int b, int& R, int& C) { const int st = b / 1024, sb = b % 1024, swz = sb ^ (((sb >> 9) & 1) << 5); R = (st >> 1) * 16 + swz / 64; C = (st & 1) * 32 + (swz % 64) / 2; }
__host__ __device__ __forceinline__ int perm32(int rho) { const int n = rho >> 4, i = rho & 15; return 8 * (i >> 2) + 4 * n + (i & 3); }
struct Unit { int pm, pn; };
struct Gemm { const bf16_t* A; const bf16_t* Bt; int M, N, K; };
struct StaticOrder {
    int nM, nN, nwg, G, c;
    __device__ void init(int M_, int N_, int G_, int c_) { nM = M_ / BM; nN = N_ / BM; nwg = nM * nN; G = G_; c = c_; }
    __device__ bool next(int i, Unit& u) const {
        const long L = (long)i * G + c; if (L >= nwg) return false;
        int wgid = (int)L; { const int q = nwg / NXCD, r = nwg % NXCD, xcd = wgid % NXCD, off = wgid / NXCD; wgid = (xcd < r ? xcd * (q + 1) : r * (q + 1) + (xcd - r) * q) + off; }
        const int nig = WGM * nN, gid = wgid / nig, fm = gid * WGM, gsz = (nM - fm) < WGM ? (nM - fm) : WGM;
        u.pm = fm + ((wgid % nig) % gsz); u.pn = (wgid % nig) / gsz; return true;
    }
};
__device__ __forceinline__ unsigned cvt_pk_bf16(float lo, float hi) { unsigned r; asm volatile("v_cvt_pk_bf16_f32 %0, %1, %2" : "=v"(r) : "v"(lo), "v"(hi)); return r; }

template <class Epi>
__device__ __forceinline__ void gemm_phase(LAS unsigned char* lds, const Gemm g, const StaticOrder& S, const Epi& E) {
    const int tid = threadIdx.x, wid = __builtin_amdgcn_readfirstlane(tid >> 6), lane = tid & 63, wr = wid >> 2, wc = wid & 3, fr = lane & 15, fq = lane >> 4;
    const int K = g.K, nt = K / BK;
    unsigned voffA[2], voffB[2];
#pragma unroll
    for (int i = 0; i < 2; ++i) { int R, C; stage_rc(tid * 16 + i * 8192, R, C); const int Rb = (R & ~31) + perm32(R & 31);
        voffA[i] = (unsigned)(R * K + C) * 2u; voffB[i] = (unsigned)(Rb * K + C) * 2u; }
    const size_t kstep = (size_t)(BK * 2);
    const size_t hstep = (size_t)HALF * K * 2;
    const size_t tstep = 2 * hstep;
    const unsigned ldsw = (unsigned)wid * 1024u;
    const int aoff = lds_byte(wr * 64 + fr, fq * 8), boff = lds_byte(wc * 32 + fr, fq * 8);
#define PG8_SA(b, h) (((b) * 2 + (h)) * HTB)
#define PG8_SB(b, h) ((4 + (b) * 2 + (h)) * HTB)
#define PG8_STAGE(bufoff, gbase, voff) do { _Pragma("unroll") for (int _i = 0; _i < 2; ++_i) \
        __builtin_amdgcn_global_load_lds((const unsigned*)((const char*)(gbase) + (voff)[_i]), (LAS unsigned*)(lds + (bufoff) + ldsw + _i * 8192), 16, 0, 0); } while (0)
#define PG8_LDA(dst, b, h) do { _Pragma("unroll") for (int m = 0; m < 4; ++m) _Pragma("unroll") for (int k = 0; k < 2; ++k) dst[m][k] = *(const LAS bf16x8*)(lds + PG8_SA(b, h) + aoff + m * 2048 + k * 1024); } while (0)
#define PG8_LDB(dst, b, h) do { _Pragma("unroll") for (int n = 0; n < 2; ++n) _Pragma("unroll") for (int k = 0; k < 2; ++k) dst[n][k] = *(const LAS bf16x8*)(lds + PG8_SB(b, h) + boff + n * 2048 + k * 1024); } while (0)
#define PG8_MMA(ai, bj, At, Bt) do { __builtin_amdgcn_s_setprio(1); _Pragma("unroll") for (int m = 0; m < 4; ++m) _Pragma("unroll") for (int n = 0; n < 2; ++n) _Pragma("unroll") for (int k = 0; k < 2; ++k) \
        acc[ai][bj][m][n] = __builtin_amdgcn_mfma_f32_16x16x32_bf16(Bt[n][k], At[m][k], acc[ai][bj][m][n], 0, 0, 0); __builtin_amdgcn_s_setprio(0); } while (0)
#define PG8_WAIT_V(n) asm volatile("s_waitcnt vmcnt(" #n ")" ::: "memory")
#define PG8_WAIT_L(n) asm volatile("s_waitcnt lgkmcnt(" #n ")" ::: "memory")
#define PG8_BAR __builtin_amdgcn_s_barrier()
#define PG8_SCHED __builtin_amdgcn_sched_barrier(0)
    Unit cur, nxt; int ui = 0;
    if (!S.next(0, cur)) return;
    f32x4 acc[2][2][4][2];
#pragma unroll
    for (int a = 0; a < 2; ++a)
#pragma unroll
        for (int b = 0; b < 2; ++b)
#pragma unroll
            for (int m = 0; m < 4; ++m)
#pragma unroll
                for (int n = 0; n < 2; ++n) acc[a][b][m][n] = (f32x4){0.f, 0.f, 0.f, 0.f};
    bf16x8 At[4][2], B0[2][2], B1[2][2];
    const char* cA = (const char*)g.A + (size_t)cur.pm * tstep; const char* cB = (const char*)g.Bt + (size_t)cur.pn * tstep;
    PG8_STAGE(PG8_SB(0, 0), cB, voffB); PG8_STAGE(PG8_SB(0, 1), cB + hstep, voffB); PG8_STAGE(PG8_SA(0, 0), cA, voffA); PG8_STAGE(PG8_SA(0, 1), cA + hstep, voffA);
    if (wr == 1) PG8_BAR;
    PG8_WAIT_V(2); PG8_BAR;
    PG8_STAGE(PG8_SB(1, 0), cB + kstep, voffB); PG8_STAGE(PG8_SA(1, 0), cA + kstep, voffA); PG8_STAGE(PG8_SB(1, 1), cB + hstep + kstep, voffB);
    PG8_WAIT_V(6); PG8_BAR;
    for (;;) {
        const bool has_next = S.next(ui + 1, nxt);
        const char* nA = has_next ? (const char*)g.A + (size_t)nxt.pm * tstep : cA; const char* nB = has_next ? (const char*)g.Bt + (size_t)nxt.pn * tstep : cB;
        for (int t = 0; t < nt; t += 2) {
            const bool last = (t == nt - 2);
            const char* a1 = cA + (size_t)(t + 1) * kstep;
            const char* a2 = last ? nA : cA + (size_t)(t + 2) * kstep; const char* b2 = last ? nB : cB + (size_t)(t + 2) * kstep;
            const char* a3 = a2 + kstep; const char* b3 = b2 + kstep;
            PG8_LDB(B0, 0, 0); PG8_LDB(B1, 0, 1); PG8_SCHED; PG8_LDA(At, 0, 0); PG8_STAGE(PG8_SA(1, 1), a1 + hstep, voffA);
            PG8_WAIT_V(8); PG8_WAIT_L(0); PG8_BAR; PG8_MMA(0, 0, At, B0); PG8_MMA(0, 1, At, B1); PG8_BAR; PG8_SCHED;
            PG8_LDA(At, 0, 1); PG8_STAGE(PG8_SB(0, 0), b2, voffB); PG8_STAGE(PG8_SB(0, 1), b2 + hstep, voffB); PG8_STAGE(PG8_SA(0, 0), a2, voffA);
            PG8_WAIT_V(8); PG8_WAIT_L(0); PG8_BAR; PG8_MMA(1, 0, At, B0); PG8_MMA(1, 1, At, B1); PG8_BAR; PG8_SCHED;
            PG8_LDB(B0, 1, 0); PG8_LDB(B1, 1, 1); PG8_SCHED; PG8_LDA(At, 1, 0); PG8_STAGE(PG8_SA(0, 1), a2 + hstep, voffA);
            PG8_WAIT_V(8); PG8_WAIT_L(0); PG8_BAR; PG8_MMA(0, 0, At, B0); PG8_MMA(0, 1, At, B1); PG8_BAR; PG8_SCHED;
            PG8_LDA(At, 1, 1); PG8_STAGE(PG8_SB(1, 0), b3, voffB); PG8_STAGE(PG8_SB(1, 1), b3 + hstep, voffB); PG8_STAGE(PG8_SA(1, 0), a3, voffA);
            PG8_WAIT_V(8); PG8_WAIT_L(0); PG8_BAR; PG8_MMA(1, 0, At, B0); PG8_MMA(1, 1, At, B1); PG8_BAR; PG8_SCHED;
        }
        if (wr == 0) PG8_BAR;
        E(acc, cur, wr, wc, fr, fq);
        if (!has_next) break;
#pragma unroll
        for (int a = 0; a < 2; ++a)
#pragma unroll
            for (int b = 0; b < 2; ++b)
#pragma unroll
                for (int m = 0; m < 4; ++m)
#pragma unroll
                    for (int n = 0; n < 2; ++n) acc[a][b][m][n] = (f32x4){0.f, 0.f, 0.f, 0.f};
        cur = nxt; cA = nA; cB = nB; ++ui;
        if (wr == 1) PG8_BAR;
    }
    PG8_WAIT_V(0);
    PG8_BAR;
#undef PG8_SA
#undef PG8_SB
#undef PG8_STAGE
#undef PG8_LDA
#undef PG8_LDB
#undef PG8_MMA
#undef PG8_WAIT_V
#undef PG8_WAIT_L
#undef PG8_BAR
#undef PG8_SCHED
}
}
typedef f32x4 Acc[2][2][4][2];

struct EpiU {
    bf16_t* Ug;
    __device__ __forceinline__ void operator()(const Acc& acc, const pg8::Unit& u, int wr, int wc, int fr, int fq) const {
#pragma unroll
        for (int ai = 0; ai < 2; ++ai)
#pragma unroll
            for (int m = 0; m < 4; ++m) { const int row = u.pm * 256 + ai * 128 + wr * 64 + m * 16 + fr;
#pragma unroll
                for (int bj = 0; bj < 2; ++bj) { const int c0 = u.pn * 256 + bj * 128 + wc * 32 + 8 * fq; const int g = c0 >> 4, half = (c0 >> 3) & 1;
                    const f32x4 v0 = acc[ai][bj][m][0], v1 = acc[ai][bj][m][1]; u32x4 w;
                    w.x = pk2(v0[0], v0[1]); w.y = pk2(v0[2], v0[3]); w.z = pk2(v1[0], v1[1]); w.w = pk2(v1[2], v1[3]);
                    *(u32x4*)(Ug + ((size_t)g * M + row) * 16 + half * 8) = w; } }
    }
};
struct EpiGLU {
    const float* bias; const float* xres; const float* gvec; bf16_t* V;
    __device__ __forceinline__ void operator()(const Acc& acc, const pg8::Unit& u, int wr, int wc, int fr, int fq) const {
        const int b = u.pm >= 32; const int p0 = u.pn * 128 + wc * 32 + 8 * fq;
        f32x4 bv[2], bg[2], gg[2];
#pragma unroll
        for (int n = 0; n < 2; ++n) { bv[n] = *(const f32x4*)(bias + p0 + 4 * n); bg[n] = *(const f32x4*)(bias + D + p0 + 4 * n); gg[n] = *(const f32x4*)(gvec + (size_t)b * 6 * D + p0 + 4 * n) + 1.0f; }
#pragma unroll
        for (int ai = 0; ai < 2; ++ai)
#pragma unroll
            for (int m = 0; m < 4; ++m) { const size_t row = u.pm * 256 + ai * 128 + wr * 64 + m * 16 + fr;
                float o[8];
#pragma unroll
                for (int n = 0; n < 2; ++n) { const f32x4 val = acc[ai][0][m][n] + bv[n], gate = acc[ai][1][m][n] + bg[n]; const f32x4 xv = *(const f32x4*)(xres + row * D + p0 + 4 * n);
#pragma unroll
                    for (int e = 0; e < 4; ++e) o[4 * n + e] = ALPHA * xv[e] + gg[n][e] * (val[e] * sigmoidf_(gate[e])); }
                u32x4 w; w.x = pk2(o[0], o[1]); w.y = pk2(o[2], o[3]); w.z = pk2(o[4], o[5]); w.w = pk2(o[6], o[7]);
                *(u32x4*)(V + row * D + p0) = w; }
    }
};
struct EpiSwiGLU {
    bf16_t* ACT;
    __device__ __forceinline__ void operator()(const Acc& acc, const pg8::Unit& u, int wr, int wc, int fr, int fq) const {
        const int p0 = u.pn * 128 + wc * 32 + 8 * fq;
#pragma unroll
        for (int ai = 0; ai < 2; ++ai)
#pragma unroll
            for (int m = 0; m < 4; ++m) { const size_t row = u.pm * 256 + ai * 128 + wr * 64 + m * 16 + fr; float o[8];
#pragma unroll
                for (int n = 0; n < 2; ++n)
#pragma unroll
                    for (int e = 0; e < 4; ++e) { const float gv = acc[ai][0][m][n][e], uv = acc[ai][1][m][n][e]; o[4 * n + e] = gv * sigmoidf_(gv) * uv; }
                u32x4 w; w.x = pk2(o[0], o[1]); w.y = pk2(o[2], o[3]); w.z = pk2(o[4], o[5]); w.w = pk2(o[6], o[7]);
                *(u32x4*)(ACT + row * DFF + p0) = w; }
    }
};
struct EpiRes {
    const bf16_t* Vprev; const f32x2* stats; const float* lg; const float* lb; const float* gvec; bf16_t* V;
    __device__ __forceinline__ void operator()(const Acc& acc, const pg8::Unit& u, int wr, int wc, int fr, int fq) const {
        const int b = u.pm >= 32;
#pragma unroll
        for (int bj = 0; bj < 2; ++bj) { const int c = u.pn * 256 + bj * 128 + wc * 32 + 8 * fq;
            f32x4 gg[2], g4[2], b4[2];
#pragma unroll
            for (int n = 0; n < 2; ++n) { gg[n] = *(const f32x4*)(gvec + (size_t)b * 6 * D + c + 4 * n) + 1.0f; g4[n] = *(const f32x4*)(lg + c + 4 * n); b4[n] = *(const f32x4*)(lb + c + 4 * n); }
#pragma unroll
            for (int ai = 0; ai < 2; ++ai)
#pragma unroll
                for (int m = 0; m < 4; ++m) { const size_t row = u.pm * 256 + ai * 128 + wr * 64 + m * 16 + fr; const f32x2 st = stats[row];
                    const u32x4 pv = *(const u32x4*)(Vprev + row * D + c); float o[8];
#pragma unroll
                    for (int n = 0; n < 2; ++n)
#pragma unroll
                        for (int e = 0; e < 4; ++e) { const unsigned wd = pv[2 * n + (e >> 1)]; const float vp = __builtin_bit_cast(float, (e & 1) ? (wd & 0xffff0000u) : (wd << 16));
                            const float xv = (vp - st.x) * st.y * g4[n][e] + b4[n][e]; o[4 * n + e] = xv * ALPHA + gg[n][e] * acc[ai][bj][m][n][e]; }
                    u32x4 w; w.x = pk2(o[0], o[1]); w.y = pk2(o[2], o[3]); w.z = pk2(o[4], o[5]); w.w = pk2(o[6], o[7]);
                    *(u32x4*)(V + row * D + c) = w; } }
    }
};
struct EpiDSA {
    bf16_t *Q, *K, *Vt, *QI, *KI; float* WI; const f32x2* CSH; const f32x2* CSI;
    __device__ __forceinline__ void operator()(const Acc& acc, const pg8::Unit& u, int wr, int wc, int fr, int fq) const {
        const int pn = u.pn;
        if (pn < 16) {
            const int pl = wc * 32 + 8 * fq, hh = pl >> 6, d0 = pl & 63, head = 2 * (pn & 7) + hh; bf16_t* dst = pn < 8 ? Q : K; const float sc = pn < 8 ? QSCALE : 1.0f;
#pragma unroll
            for (int ai = 0; ai < 2; ++ai)
#pragma unroll
                for (int m = 0; m < 4; ++m) { const size_t row = u.pm * 256 + ai * 128 + wr * 64 + m * 16 + fr; float o1[8], o2[8];
#pragma unroll
                    for (int n = 0; n < 2; ++n)
#pragma unroll
                        for (int e = 0; e < 4; ++e) { const f32x2 cs = CSH[row * 64 + d0 + 4 * n + e]; const float a = acc[ai][0][m][n][e], bb = acc[ai][1][m][n][e];
                            o1[4 * n + e] = (a * cs.x - bb * cs.y) * sc; o2[4 * n + e] = (bb * cs.x + a * cs.y) * sc; }
                    u32x4 w1, w2; w1.x = pk2(o1[0], o1[1]); w1.y = pk2(o1[2], o1[3]); w1.z = pk2(o1[4], o1[5]); w1.w = pk2(o1[6], o1[7]);
                    w2.x = pk2(o2[0], o2[1]); w2.y = pk2(o2[2], o2[3]); w2.z = pk2(o2[4], o2[5]); w2.w = pk2(o2[6], o2[7]);
                    bf16_t* p = dst + row * D + head * 128 + d0; *(u32x4*)p = w1; *(u32x4*)(p + 64) = w2; }
        } else if (pn < 24) {
#pragma unroll
            for (int ai = 0; ai < 2; ++ai)
#pragma unroll
                for (int m = 0; m < 4; ++m) { const int row = u.pm * 256 + ai * 128 + wr * 64 + m * 16 + fr; const int b = row >> 13, t = row & (SEQ - 1); const int tp = (t & ~15) | ((((t >> 2) & 1) << 1 | ((t >> 3) & 1)) << 2) | (t & 3);
#pragma unroll
                    for (int bj = 0; bj < 2; ++bj)
#pragma unroll
                        for (int n = 0; n < 2; ++n)
#pragma unroll
                            for (int e = 0; e < 4; ++e) { const int c = (pn - 16) * 256 + bj * 128 + wc * 32 + 8 * fq + 4 * n + e; const int head = c >> 7, d = c & 127;
                                Vt[((size_t)((b * 16 + head) * 128 + d)) * SEQ + tp] = (bf16_t)f2bf(acc[ai][bj][m][n][e]); } }
        } else if (pn < 28) {
            const int ih = 4 * (pn - 24) + wc, d0 = 8 * fq;
#pragma unroll
            for (int ai = 0; ai < 2; ++ai)
#pragma unroll
                for (int m = 0; m < 4; ++m) { const size_t row = u.pm * 256 + ai * 128 + wr * 64 + m * 16 + fr; float o1[8], o2[8];
#pragma unroll
                    for (int n = 0; n < 2; ++n)
#pragma unroll
                        for (int e = 0; e < 4; ++e) { const f32x2 cs = CSI[row * 32 + d0 + 4 * n + e]; const float a = acc[ai][0][m][n][e], bb = acc[ai][1][m][n][e];
                            o1[4 * n + e] = (a * cs.x - bb * cs.y) * 0.125f; o2[4 * n + e] = (bb * cs.x + a * cs.y) * 0.125f; }
                    u32x4 w1, w2; w1.x = pk2(o1[0], o1[1]); w1.y = pk2(o1[2], o1[3]); w1.z = pk2(o1[4], o1[5]); w1.w = pk2(o1[6], o1[7]);
                    w2.x = pk2(o2[0], o2[1]); w2.y = pk2(o2[2], o2[3]); w2.z = pk2(o2[4], o2[5]); w2.w = pk2(o2[6], o2[7]);
                    bf16_t* p = QI + row * 1024 + ih * 64 + d0; *(u32x4*)p = w1; *(u32x4*)(p + 32) = w2; }
        } else {
            if (wc == 0) {
                const int d0 = 8 * fq;
#pragma unroll
                for (int ai = 0; ai < 2; ++ai)
#pragma unroll
                    for (int m = 0; m < 4; ++m) { const size_t row = u.pm * 256 + ai * 128 + wr * 64 + m * 16 + fr; float o1[8], o2[8];
#pragma unroll
                        for (int n = 0; n < 2; ++n)
#pragma unroll
                            for (int e = 0; e < 4; ++e) { const f32x2 cs = CSI[row * 32 + d0 + 4 * n + e]; const float a = acc[ai][0][m][n][e], bb = acc[ai][1][m][n][e];
                                o1[4 * n + e] = a * cs.x - bb * cs.y; o2[4 * n + e] = bb * cs.x + a * cs.y; }
                        u32x4 w1, w2; w1.x = pk2(o1[0], o1[1]); w1.y = pk2(o1[2], o1[3]); w1.z = pk2(o1[4], o1[5]); w1.w = pk2(o1[6], o1[7]);
                        w2.x = pk2(o2[0], o2[1]); w2.y = pk2(o2[2], o2[3]); w2.z = pk2(o2[4], o2[5]); w2.w = pk2(o2[6], o2[7]);
                        bf16_t* p = KI + row * 64 + d0; *(u32x4*)p = w1; *(u32x4*)(p + 32) = w2; }
            } else if (wc == 1 && fq < 2) {
#pragma unroll
                for (int ai = 0; ai < 2; ++ai)
#pragma unroll
                    for (int m = 0; m < 4; ++m) { const size_t row = u.pm * 256 + ai * 128 + wr * 64 + m * 16 + fr;
#pragma unroll
                        for (int n = 0; n < 2; ++n) *(f32x4*)(WI + row * 16 + 8 * fq + 4 * n) = acc[ai][0][m][n] * 0.25f; }
            }
        }
    }
};

__device__ __forceinline__ int dest_row(int mode, int n) {
    if (mode == 0) return n;
    if (mode == 1) { const int s = n >= 2048, p = n - s * 2048; return 256 * (p >> 7) + 128 * s + (p & 127); }
    if (mode == 2) { const int s = n >= DFF, p = n - s * DFF; return 256 * (p >> 7) + 128 * s + (p & 127); }
    if (n < 4096) { const int blk = n >> 11, w = n & 2047, head = w >> 7, e = w & 127, s = e >> 6, d = e & 63; return blk * 2048 + 256 * (head >> 1) + 128 * s + 64 * (head & 1) + d; }
    if (n < 6144) return n;
    if (n < 7168) { const int mm = n - 6144, ih = mm >> 6, e = mm & 63, s = e >> 5, d = e & 31; return 6144 + 256 * (ih >> 2) + 128 * s + 32 * (ih & 3) + d; }
    if (n < 7184) return 7168 + 32 + (n - 7168);
    { const int mm = n - 7184, s = mm >> 5, d = mm & 31; return 7168 + 128 * s + d; }
}
__device__ __forceinline__ void transpose_item(const float* W, int K, int N, bf16_t* WT, int mode, LAS float* scr, int item, int lane) {
    const int nblk = (N + 31) / 32, kb = item / nblk, nb = item % nblk, k0 = 64 * kb, n0 = 32 * nb;
    const int nn = n0 + (lane & 31); const bool okn = nn < N;
    float tv[32];
#pragma unroll
    for (int i = 0; i < 32; ++i) { const int kk = 2 * i + (lane >> 5); tv[i] = okn ? W[(size_t)(k0 + kk) * N + nn] : 0.f; }
#pragma unroll
    for (int i = 0; i < 32; ++i) { const int kk = 2 * i + (lane >> 5); scr[kk * 33 + (lane & 31)] = tv[i]; }
    asm volatile("s_waitcnt lgkmcnt(0)" ::: "memory");
    const int c = lane & 7;
#pragma unroll
    for (int j = 0; j < 4; ++j) { const int n = (lane >> 3) + 8 * j; const LAS float* s = scr + (8 * c) * 33 + n;
        u32x4 o; o.x = pk2(s[0 * 33], s[1 * 33]); o.y = pk2(s[2 * 33], s[3 * 33]); o.z = pk2(s[4 * 33], s[5 * 33]); o.w = pk2(s[6 * 33], s[7 * 33]);
        if (n0 + n < N) *(u32x4*)(WT + (size_t)dest_row(mode, n0 + n) * K + k0 + 8 * c) = o; }
    asm volatile("s_waitcnt lgkmcnt(0)" ::: "memory");
}

__device__ __forceinline__ void mod_item(const Params& P, int item, LAS float* lds) {
    const int tid = threadIdx.x; const int layer = item / 96, cb = item % 96;
    LAS float* cact = lds;
    LAS float* red = lds + 4096;
    for (int i = tid; i < 2 * D; i += NTHR) { const float v = P.c[i]; cact[i] = v * sigmoidf_(v); }
    __syncthreads();
    const int cq = tid & 31, ks = tid >> 5; const int col = cb * 128 + cq * 4;
    const float* W = P.ada_w + (size_t)layer * D * 6 * D + col;
    f32x4 a0 = {0.f, 0.f, 0.f, 0.f}, a1 = {0.f, 0.f, 0.f, 0.f};
#pragma unroll 16
    for (int k = ks * 128; k < ks * 128 + 128; ++k) { const f32x4 w = *(const f32x4*)(W + (size_t)k * 6 * D); a0 += w * cact[k]; a1 += w * cact[D + k]; }
    *(LAS f32x4*)(red + (ks * 2 + 0) * 128 + cq * 4) = a0; *(LAS f32x4*)(red + (ks * 2 + 1) * 128 + cq * 4) = a1;
    __syncthreads();
    if (tid < 256) { const int b = tid >> 7, cc = tid & 127; float s = P.ada_b[layer * 6 * D + cb * 128 + cc];
#pragma unroll
        for (int k = 0; k < 16; ++k) s += red[(k * 2 + b) * 128 + cc];
        ((float*)(P.ws + OFF_MOD))[(size_t)(layer * 2 + b) * 6 * D + cb * 128 + cc] = s; }
    __syncthreads();
}

__device__ __forceinline__ void s5_table_item(const Params& P, int g, LAS float* lds) {
    const int tid = threadIdx.x;
    LAS f32x2* pw = (LAS f32x2*)lds;
    LAS f32x2* bb = pw + 33 * 64;
    LAS f32x2* cc = bb + 64 * 16;
    {
        const double dt = exp((double)P.log_dt[g]);
#pragma unroll 1
        for (int idx = tid; idx < 33 * 64; idx += NTHR) { const int k = idx >> 6, n = idx & 63;
            const double zre = (double)P.a_re[g * 64 + n] * dt, zim = (double)P.a_im[g * 64 + n] * dt;
            const float mag = (float)exp(zre * k); float sn, cs; sincos_rev(zim * k * 0.15915494309189535, sn, cs); pw[k * 64 + n] = (f32x2){mag * cs, mag * sn}; }
    }
    __syncthreads();
#pragma unroll 1
    for (int i = tid; i < 64 * 16; i += NTHR) { const int n = i >> 4;
        const float are = P.a_re[g * 64 + n], aim = P.a_im[g * 64 + n]; const f32x2 lb = pw[64 + n];
        const float nr = lb.x - 1.0f, ni = lb.y, den = are * are + aim * aim;
        const float fr_ = (nr * are + ni * aim) / den, fi_ = (ni * are - nr * aim) / den;
        const float br = P.b_re[(size_t)g * 1024 + i], bi = P.b_im[(size_t)g * 1024 + i];
        bb[i] = (f32x2){fr_ * br - fi_ * bi, fr_ * bi + fi_ * br};
        cc[i] = (f32x2){P.c_re[(size_t)g * 1024 + i], P.c_im[(size_t)g * 1024 + i]}; }
    __syncthreads();
    bf16_t* WE = (bf16_t*)(P.ws + OFF_WE) + (size_t)g * 128 * 512;
    bf16_t* WP = (bf16_t*)(P.ws + OFF_WP) + (size_t)g * 512 * 128;
    bf16_t* KM = (bf16_t*)(P.ws + OFF_KM) + (size_t)g * 32 * 256;
#pragma unroll 2
    for (int idx = tid; idx < 128 * 512; idx += NTHR) { const int np = idx >> 9, jp = idx & 511, j = jp >> 4, p = jp & 15, n = np & 63;
        const f32x2 l = pw[(31 - j) * 64 + n], b = bb[n * 16 + p]; const float re = l.x * b.x - l.y * b.y, im = l.x * b.y + l.y * b.x;
        WE[idx] = (bf16_t)f2bf(np < 64 ? re : im); }
#pragma unroll 2
    for (int idx = tid; idx < 512 * 128; idx += NTHR) { const int jp = idx >> 7, np = idx & 127, j = jp >> 4, p = jp & 15, n = np & 63;
        const f32x2 l = pw[(j + 1) * 64 + n], c = cc[p * 64 + n]; const float re = l.x * c.x - l.y * c.y, im = l.x * c.y + l.y * c.x;
        WP[idx] = (bf16_t)f2bf(np < 64 ? re : -im); }
#pragma unroll 1
    for (int idx = tid; idx < 32 * 256; idx += NTHR) { const int tau = idx >> 8, p = (idx >> 4) & 15, q = idx & 15; float s = 0.f;
#pragma unroll 4
        for (int n = 0; n < 64; ++n) { const f32x2 l = pw[tau * 64 + n], c = cc[p * 64 + n], b = bb[n * 16 + q];
            const float tr = c.x * l.x - c.y * l.y, ti = c.x * l.y + c.y * l.x; s += tr * b.x - ti * b.y; }
        KM[idx] = (bf16_t)f2bf(s); }
    if (tid < 64) ((f32x2*)(P.ws + OFF_LAMT))[g * 64 + tid] = pw[32 * 64 + tid];
    __syncthreads();
}

__device__ __forceinline__ void rope_item(const Params& P, int item, int lane) {
    f32x2* CSH = (f32x2*)(P.ws + OFF_CSH); f32x2* CSI = (f32x2*)(P.ws + OFF_CSI);
    const float invh = 1.0f / powf(10000.0f, (float)(2 * lane) / 128.0f);
    const float invi = 1.0f / powf(10000.0f, (float)(2 * (lane & 31)) / 64.0f);
    for (int r = 0; r < 64; ++r) { const int row = item * 64 + r; const float pos = (float)P.pos[row];
        { const float ang = pos * invh; float s, c; sincos_rev((double)ang * 0.15915494309189535, s, c); CSH[(size_t)row * 64 + lane] = (f32x2){c, s}; }
        if (lane < 32) { const float ang = pos * invi; float s, c; sincos_rev((double)ang * 0.15915494309189535, s, c); CSI[(size_t)row * 32 + lane] = (f32x2){c, s}; } }
}

template <int MODE>
__device__ __forceinline__ void row_pass(const void* src, const float* lg, const float* lb, const float* sc, const float* sh, float* Xout, bf16_t* HB, int G) {
    const int lane = threadIdx.x & 63, wave = threadIdx.x >> 6; const int gw = blockIdx.x * NW + wave, NGW = G * NW;
    for (int m = gw; m < M; m += NGW) {
        const int b = m >> 13;
        f32x4 v[8];
        if (MODE == 0) { const f32x4* xr = (const f32x4*)((const float*)src + (size_t)m * D) + lane;
#pragma unroll
            for (int j = 0; j < 8; ++j) v[j] = xr[64 * j]; }
        else { const u32x4* xr = (const u32x4*)((const bf16_t*)src + (size_t)m * D) + lane;
#pragma unroll
            for (int j = 0; j < 4; ++j) { const u32x4 p = xr[64 * j];
                v[2 * j] = (f32x4){__builtin_bit_cast(float, p.x << 16), __builtin_bit_cast(float, p.x & 0xffff0000u), __builtin_bit_cast(float, p.y << 16), __builtin_bit_cast(float, p.y & 0xffff0000u)};
                v[2 * j + 1] = (f32x4){__builtin_bit_cast(float, p.z << 16), __builtin_bit_cast(float, p.z & 0xffff0000u), __builtin_bit_cast(float, p.w << 16), __builtin_bit_cast(float, p.w & 0xffff0000u)}; } }
#define RP_IDX(j) (MODE == 0 ? (lane + 64 * (j)) : (2 * (lane + 64 * ((j) >> 1)) + ((j) & 1)))
        if (MODE != 0) {
            float s = 0.f;
#pragma unroll
            for (int j = 0; j < 8; ++j) s += (v[j].x + v[j].y) + (v[j].z + v[j].w);
            const float mean = wave_sum(s) * (1.f / D); float s2 = 0.f;
#pragma unroll
            for (int j = 0; j < 8; ++j) { v[j] = v[j] - mean; s2 += (v[j].x * v[j].x + v[j].y * v[j].y) + (v[j].z * v[j].z + v[j].w * v[j].w); }
            const float rstd = 1.f / sqrtf(wave_sum(s2) * (1.f / D) + LN_EPS);
#pragma unroll
            for (int j = 0; j < 8; ++j) { const f32x4 gg = *((const f32x4*)lg + RP_IDX(j)), bb = *((const f32x4*)lb + RP_IDX(j)); v[j] = v[j] * rstd * gg + bb;
                if (MODE == 2) *((f32x4*)(Xout + (size_t)m * D) + RP_IDX(j)) = v[j]; }
            if (MODE == 1 && lane == 0) ((f32x2*)Xout)[m] = (f32x2){mean, rstd};
        }
        if (MODE != 2) {
#pragma unroll
            for (int j = 0; j < 8; ++j) { const f32x4 s1 = *((const f32x4*)(sc + (size_t)b * 6 * D) + RP_IDX(j)) + 1.0f, s0 = *((const f32x4*)(sh + (size_t)b * 6 * D) + RP_IDX(j));
                const f32x4 h = v[j] * s1 + s0; u32x2 w; w.x = pk2(h.x, h.y); w.y = pk2(h.z, h.w);
                *((u32x2*)(HB + (size_t)m * D) + RP_IDX(j)) = w; }
        }
#undef RP_IDX
    }
}

__device__ __forceinline__ float gelu_tanh(float x) { const float z = 0.7978845608028654f * (x + 0.044715f * x * x * x); return x * __builtin_amdgcn_rcpf(1.0f + __expf(-2.0f * z)); }
__device__ __forceinline__ void s5_item(const Params& P, int g, int b, LAS unsigned char* ldsb) {
    const int tid = threadIdx.x, lane = tid & 63, w = tid >> 6, r32 = lane & 31, hh = lane >> 5;
    LAS float* E = (LAS float*)ldsb;
    const bf16_t* Ug = (const bf16_t*)(P.ws + OFF_UG) + ((size_t)g * M + (size_t)b * SEQ) * 16;
    const bf16_t* WE = (const bf16_t*)(P.ws + OFF_WE) + (size_t)g * 128 * 512;
    const bf16_t* WP = (const bf16_t*)(P.ws + OFF_WP) + (size_t)g * 512 * 128;
    const bf16_t* KM = (const bf16_t*)(P.ws + OFF_KM) + (size_t)g * 32 * 256;
    bf16_t* Gout = (bf16_t*)(P.ws + OFF_G);
    const int c = 32 * w + r32;
    const bf16_t* ucol = Ug + (size_t)c * CH_T * 16 + 8 * hh;
    {
        f32x16 acc[4];
#pragma unroll
        for (int rb = 0; rb < 4; ++rb)
#pragma unroll
            for (int i = 0; i < 16; ++i) acc[rb][i] = 0.f;
#pragma unroll 4
        for (int ks = 0; ks < 32; ++ks) {
            const bf16x8 bf = *(const bf16x8*)(ucol + ks * 16);
#pragma unroll
            for (int rb = 0; rb < 4; ++rb) { const bf16x8 af = *(const bf16x8*)(WE + (size_t)(32 * rb + r32) * 512 + 16 * ks + 8 * hh); acc[rb] = mfma32(af, bf, acc[rb]); }
        }
#pragma unroll
        for (int rb = 0; rb < 4; ++rb)
#pragma unroll
            for (int i = 0; i < 4; ++i) *(LAS f32x4*)(E + c * ESTR + 32 * rb + 8 * i + 4 * hh) = (f32x4){acc[rb][4 * i], acc[rb][4 * i + 1], acc[rb][4 * i + 2], acc[rb][4 * i + 3]};
    }
    __syncthreads();
    if (w == 0) {
        const f32x2 lt = ((const f32x2*)(P.ws + OFF_LAMT))[g * 64 + lane]; float sr = 0.f, si = 0.f;
        for (int cc = 0; cc < NCH; ++cc) {
            const float er = E[cc * ESTR + lane], ei = E[cc * ESTR + 64 + lane];
            __builtin_amdgcn_wave_barrier();
            LAS bf16_t* pp = (LAS bf16_t*)(E + cc * ESTR); pp[lane] = (bf16_t)f2bf(sr); pp[64 + lane] = (bf16_t)f2bf(si);
            const float nr = lt.x * sr - lt.y * si + er, ni = lt.x * si + lt.y * sr + ei; sr = nr; si = ni;
        }
    }
    __syncthreads();
    {
        bf16x8 pf[8];
#pragma unroll
        for (int ks = 0; ks < 8; ++ks) pf[ks] = *(const LAS bf16x8*)((LAS unsigned char*)(E + c * ESTR) + 32 * ks + 16 * hh);
        const int jr = r32 >> 4, pr = r32 & 15;
        for (int Jg = 0; Jg < 4; ++Jg) {
            f32x16 acc[4];
#pragma unroll
            for (int jb = 0; jb < 4; ++jb)
#pragma unroll
                for (int i = 0; i < 16; ++i) acc[jb][i] = 0.f;
#pragma unroll
            for (int jb = 0; jb < 4; ++jb) { const int J = 4 * Jg + jb;
#pragma unroll
                for (int ks = 0; ks < 8; ++ks) { const bf16x8 af = *(const bf16x8*)(WP + (size_t)(32 * J + r32) * 128 + 16 * ks + 8 * hh); acc[jb] = mfma32(af, pf[ks], acc[jb]); } }
            const int imax = 8 * Jg + 7;
            for (int i = 0; i <= imax; ++i) {
                const bf16x8 bf = *(const bf16x8*)(ucol + i * 16);
#pragma unroll
                for (int jb = 0; jb < 4; ++jb) { const int J = 4 * Jg + jb;
                    if (i <= 2 * J + 1) { const int tau = 2 * J + jr - i; bf16x8 af = {0, 0, 0, 0, 0, 0, 0, 0};
                        if (tau >= 0) af = *(const bf16x8*)(KM + (size_t)tau * 256 + pr * 16 + 8 * hh);
                        acc[jb] = mfma32(af, bf, acc[jb]); } }
            }
#pragma unroll
            for (int jb = 0; jb < 4; ++jb) { const int J = 4 * Jg + jb;
#pragma unroll
                for (int i4 = 0; i4 < 4; ++i4) { const int jj = i4 >> 1, p0 = 8 * (i4 & 1) + 4 * hh; const int tok = c * CH_T + 2 * J + jj; const int ch0 = g * 16 + p0;
                    const u32x2 uu = *(const u32x2*)(Ug + (size_t)tok * 16 + p0); const f32x4 dsk = *(const f32x4*)(P.s5_d + ch0);
                    const float u0 = __builtin_bit_cast(float, uu.x << 16), u1 = __builtin_bit_cast(float, uu.x & 0xffff0000u), u2 = __builtin_bit_cast(float, uu.y << 16), u3 = __builtin_bit_cast(float, uu.y & 0xffff0000u);
                    const float y0 = gelu_tanh(acc[jb][4 * i4] + dsk.x * u0), y1 = gelu_tanh(acc[jb][4 * i4 + 1] + dsk.y * u1), y2 = gelu_tanh(acc[jb][4 * i4 + 2] + dsk.z * u2), y3 = gelu_tanh(acc[jb][4 * i4 + 3] + dsk.w * u3);
                    u32x2 o; o.x = pk2(y0, y1); o.y = pk2(y2, y3);
                    *(u32x2*)(Gout + ((size_t)b * SEQ + tok) * D + ch0) = o; } }
        }
    }
    __syncthreads();
}

__device__ __forceinline__ unsigned ordkey(float f) { const unsigned u = __builtin_bit_cast(unsigned, f); return (u & 0x80000000u) ? ~u : (u | 0x80000000u); }
#define LDS_ADD1(p) ((void)__hip_atomic_fetch_add((p), 1u, __ATOMIC_RELAXED, __HIP_MEMORY_SCOPE_WORKGROUP))
template <int NB>
__device__ __forceinline__ void radix_pass(const float* s, int n, int nch, int shift, int hshift, unsigned hval, LAS unsigned* hist, int lane, unsigned& K, unsigned& binout) {
    constexpr int BPL = NB / 64;
#pragma unroll
    for (int j = 0; j < BPL; ++j) hist[lane + 64 * j] = 0u;
    __builtin_amdgcn_wave_barrier();
#pragma unroll 1
    for (int base = 0; base < nch; base += 16) {
        float v[16];
#pragma unroll
        for (int j = 0; j < 16; ++j) { const int i = 64 * (base + j) + lane; v[j] = (i < n) ? s[i] : __builtin_nanf(""); }
#pragma unroll
        for (int j = 0; j < 16; ++j) { const int i = 64 * (base + j) + lane; const unsigned kk = ordkey(v[j]); const bool ok = (i < n) && ((hshift >= 32) || ((kk >> hshift) == hval));
            if (ok) LDS_ADD1(hist + ((kk >> shift) & (NB - 1))); }
    }
    __builtin_amdgcn_wave_barrier();
    asm volatile("s_waitcnt lgkmcnt(0)" ::: "memory");
    unsigned sl = 0;
#pragma unroll
    for (int j = 0; j < BPL; ++j) sl += hist[lane * BPL + j];
    unsigned inc = sl;
#pragma unroll
    for (int off = 1; off < 64; off <<= 1) { const unsigned t = __shfl_down(inc, off); if (lane + off < 64) inc += t; }
    const unsigned above = inc - sl;
    const bool mine = (above < K) && (K <= inc);
    unsigned bin = 0, krem = 0;
    if (mine) { unsigned cum = above; bool found = false;
        for (int j = BPL - 1; j >= 0; --j) { const unsigned cnt = hist[lane * BPL + j]; if (!found && cum + cnt >= K) { found = true; bin = lane * BPL + j; krem = K - cum; } cum += cnt; } }
    const unsigned long long bm = __ballot(mine); const int src = bm ? (__ffsll((long long)bm) - 1) : 0;
    binout = __shfl(bin, src); K = __shfl(krem, src);
    __builtin_amdgcn_wave_barrier();
}
__device__ __forceinline__ void select_query(const float* s, int b, int t, LAS unsigned* hist, int lane, unsigned long long* MASK) {
    const int n = t + 1; const int nch_tot = ((t >> 8) + 1) * 4; const int nch = (n + 63) >> 6;
    unsigned long long* mp = MASK + (size_t)b * 128 * SEQ + t;
    if (n <= 256) {
        for (int ch = 0; ch < nch_tot; ++ch) { const int i = 64 * ch + lane; const unsigned long long wd = __ballot(i < n); if (lane == 0) mp[(size_t)ch * SEQ] = wd; }
        return;
    }
    unsigned K = 256, b1, b2, b3;
    radix_pass<2048>(s, n, nch, 21, 32, 0u, hist, lane, K, b1);
    radix_pass<2048>(s, n, nch, 10, 21, b1, hist, lane, K, b2);
    radix_pass<1024>(s, n, nch, 0, 10, (b1 << 11) | b2, hist, lane, K, b3);
    const unsigned T = (b1 << 21) | (b2 << 10) | b3; unsigned running = 0;
#pragma unroll 1
    for (int base = 0; base < nch_tot; base += 16) {
        float v[16];
#pragma unroll
        for (int j = 0; j < 16; ++j) { const int i = 64 * (base + j) + lane; v[j] = (i < n) ? s[i] : __builtin_nanf(""); }
#pragma unroll
        for (int j = 0; j < 16; ++j) { const int i = 64 * (base + j) + lane; const unsigned kk = ordkey(v[j]); const bool valid = i < n;
            const bool gt = valid && kk > T, eq = valid && kk == T; const unsigned long long em = __ballot(eq);
            const unsigned rank = running + (unsigned)__popcll(em & ((1ull << lane) - 1ull));
            const unsigned long long wd = __ballot(gt || (eq && rank < K)); if (lane == 0 && base + j < nch_tot) mp[(size_t)(base + j) * SEQ] = wd; running += (unsigned)__popcll(em); }
    }
}
constexpr int IX_SK = 256, IX_RSTR = 144, IX_STAGE = IX_SK * IX_RSTR;
__device__ __forceinline__ float relu_asm(float x) { return __builtin_amdgcn_fmed3f(x, 0.f, __builtin_inff()); }
__device__ __forceinline__ void indexer_block(const Params& P, int b, int blk, LAS unsigned char* ldsb) {
    const int tid = threadIdx.x, lane = tid & 63, w = tid >> 6, r32 = lane & 31, hh = lane >> 5;
    const bf16_t* QI = (const bf16_t*)(P.ws + OFF_QI); const bf16_t* KI = (const bf16_t*)(P.ws + OFF_KI); const float* WI = (const float*)(P.ws + OFF_WI);
    float* scr = (float*)(P.ws + OFF_SCR) + (size_t)blockIdx.x * 16 * SEQ;
    const int t0 = 16 * blk; const int qq = r32 >> 4, head = r32 & 15;
    const size_t qrow = (size_t)b * SEQ + t0 + 2 * w;
    bf16x8 af[4];
#pragma unroll
    for (int ks = 0; ks < 4; ++ks) af[ks] = *(const bf16x8*)(QI + (qrow + qq) * 1024 + head * 64 + 16 * ks + 8 * hh);
    f32x4 wv[2][2];
#pragma unroll
    for (int q2 = 0; q2 < 2; ++q2) { wv[q2][0] = *(const f32x4*)(WI + (qrow + q2) * 16 + 4 * hh); wv[q2][1] = *(const f32x4*)(WI + (qrow + q2) * 16 + 8 + 4 * hh); }
    const int nt = (t0 + 16 + 31) >> 5;
    const int nst = (nt + 7) >> 3;
    float* srow = scr + (size_t)(2 * w + hh) * SEQ + r32;
    const bf16_t* kg = KI + (size_t)b * SEQ * 64;
    u32x4 rg[4];
#define IX_GLOAD(st) do { _Pragma("unroll") for (int i = 0; i < 4; ++i) { const int idx = tid + 512 * i; rg[i] = *(const u32x4*)(kg + ((size_t)(st) * IX_SK + (idx >> 3)) * 64 + 8 * (idx & 7)); } } while (0)
#define IX_LWRITE(buf) do { _Pragma("unroll") for (int i = 0; i < 4; ++i) { const int idx = tid + 512 * i; *(LAS u32x4*)(ldsb + (buf) * IX_STAGE + (idx >> 3) * IX_RSTR + 16 * (idx & 7)) = rg[i]; } } while (0)
#ifndef IX_REP
#define IX_REP 1
#endif
    for (int rep_ = 0; rep_ < IX_REP; ++rep_) {
    __syncthreads();
    IX_GLOAD(0); IX_LWRITE(0);
    __syncthreads();
    for (int st = 0; st < nst; ++st) {
        if (st + 1 < nst) IX_GLOAD(st + 1);
        const LAS unsigned char* kb = ldsb + (st & 1) * IX_STAGE + r32 * IX_RSTR + 16 * hh;
#pragma unroll
        for (int jg = 0; jg < 2; ++jg) {
            if (8 * st + 4 * jg < nt) {
                f32x16 acc[4];
#pragma unroll
                for (int j = 0; j < 4; ++j)
#pragma unroll
                    for (int i = 0; i < 16; ++i) acc[j][i] = 0.f;
#pragma unroll
                for (int ks = 0; ks < 4; ++ks)
#pragma unroll
                    for (int j = 0; j < 4; ++j) { const bf16x8 bf = *(const LAS bf16x8*)(kb + (4 * jg + j) * 32 * IX_RSTR + 32 * ks); acc[j] = mfma32(af[ks], bf, acc[j]); }
                float mine[4];
#pragma unroll
                for (int j = 0; j < 4; ++j) { float p0 = 0.f, p1 = 0.f;
#pragma unroll
                    for (int i = 0; i < 4; ++i) {
                        float r0 = relu_asm(acc[j][i]), r1 = relu_asm(acc[j][4 + i]), r2 = relu_asm(acc[j][8 + i]), r3 = relu_asm(acc[j][12 + i]);
                        float w0 = wv[0][0][i], w1 = wv[0][1][i], w2 = wv[1][0][i], w3 = wv[1][1][i];
                        asm("v_fmac_f32 %0, %1, %2" : "+v"(p0) : "v"(w0), "v"(r0)); asm("v_fmac_f32 %0, %1, %2" : "+v"(p1) : "v"(w2), "v"(r2));
                        asm("v_fmac_f32 %0, %1, %2" : "+v"(p0) : "v"(w1), "v"(r1)); asm("v_fmac_f32 %0, %1, %2" : "+v"(p1) : "v"(w3), "v"(r3)); }
                    const float send = hh ? p0 : p1; mine[j] = (hh ? p1 : p0); acc[j][0] = send; }
#pragma unroll
                for (int j = 0; j < 4; ++j) { const float recv = __shfl_xor(acc[j][0], 32); const int kt = 8 * st + 4 * jg + j; if (kt < nt) srow[32 * kt] = mine[j] + recv; }
            } }
        if (st + 1 < nst) IX_LWRITE((st + 1) & 1);
        __syncthreads();
    }
    }
#undef IX_GLOAD
#undef IX_LWRITE
    asm volatile("s_waitcnt vmcnt(0)" ::: "memory");
    __builtin_amdgcn_fence(__ATOMIC_ACQUIRE, "agent");
    asm volatile("s_waitcnt vmcnt(0)" ::: "memory");
    LAS unsigned* hist = (LAS unsigned*)(ldsb + 2 * IX_STAGE) + w * 2048;
    unsigned long long* MASK = (unsigned long long*)(P.ws + OFF_MASK);
    select_query(scr + (size_t)(2 * w) * SEQ, b, t0 + 2 * w, hist, lane, MASK);
    select_query(scr + (size_t)(2 * w + 1) * SEQ, b, t0 + 2 * w + 1, hist, lane, MASK);
}

constexpr int ATT_STAGE = 32768, ATT_VOFF = 16384, ATT_NS = 4;
__device__ __forceinline__ unsigned cvtpk(float lo, float hi) { f32x2 v = {lo, hi}; bf16x2_t b = __builtin_convertvector(v, bf16x2_t); return __builtin_bit_cast(unsigned, b); }
__device__ __forceinline__ void attn_unit(const Params& P, int b, int h, int qb, bool desc, LAS unsigned char* ldsb) {
    const int tid = threadIdx.x, lane = tid & 63, w = __builtin_amdgcn_readfirstlane(tid >> 6), r32 = lane & 31, hh = lane >> 5;
    const bf16_t* Q = (const bf16_t*)(P.ws + OFF_Q); const bf16_t* Kg = (const bf16_t*)(P.ws + OFF_K); const bf16_t* Vt = (const bf16_t*)(P.ws + OFF_VT);
    const unsigned long long* MASK = (const unsigned long long*)(P.ws + OFF_MASK);
    const int q0 = qb * 256; const size_t qrow = (size_t)b * SEQ + q0 + 32 * w + r32;
    const int NT = 4 * qb + 4;
    const bf16_t* Kbase = Kg + ((size_t)b * SEQ) * D + h * 128;
    const bf16_t* Vbase = Vt + ((size_t)(b * 16 + h) * 128) * SEQ;
    const unsigned* mrow32 = (const unsigned*)(MASK + (size_t)b * 128 * SEQ + q0 + 32 * w) + lane;
    constexpr int ATT_MOFF = ATT_NS * ATT_STAGE;
    unsigned ksrc[2], vsrc[2];
#pragma unroll
    for (int i = 0; i < 2; ++i) { const int ki = 2 * w + i; const int krow = 4 * ki + (lane >> 4), kch = (lane & 15) ^ (krow & 15); ksrc[i] = (unsigned)(krow * D + 8 * kch);
        const int vrow = 8 * ki + (lane >> 3), vch = (lane & 7) ^ ((vrow >> 1) & 7); vsrc[i] = (unsigned)(vrow * SEQ + 8 * vch); }
#define AT_DMA(tt, slot) do { _Pragma("unroll") for (int i = 0; i < 2; ++i) { \
        __builtin_amdgcn_global_load_lds((const unsigned*)(Kbase + (size_t)(tt) * 64 * D + ksrc[i]), (LAS unsigned*)(ldsb + (slot) * ATT_STAGE + (2 * w + i) * 1024), 16, 0, 0); \
        __builtin_amdgcn_global_load_lds((const unsigned*)(Vbase + (size_t)(tt) * 64 + vsrc[i]), (LAS unsigned*)(ldsb + (slot) * ATT_STAGE + ATT_VOFF + (2 * w + i) * 1024), 16, 0, 0); } \
        __builtin_amdgcn_global_load_lds(mrow32 + (size_t)(tt) * SEQ * 2, (LAS unsigned*)(ldsb + ATT_MOFF + (slot) * 2048 + w * 256), 4, 0, 0); } while (0)
    const int kbase0 = r32 * 256 + 16 * (hh ^ (r32 & 15));
    const int vbase0 = ATT_VOFF + r32 * 128 + 16 * (hh ^ ((r32 >> 1) & 7));
    asm volatile("s_waitcnt vmcnt(0) lgkmcnt(0)\n\ts_barrier" ::: "memory");
    bf16x8 qf[8];
#pragma unroll
    for (int ks = 0; ks < 8; ++ks) qf[ks] = *(const bf16x8*)(Q + qrow * D + h * 128 + 16 * ks + 8 * hh);
#define AT_TILE(i) (desc ? (NT - 1 - (i)) : (i))
    AT_DMA(AT_TILE(0), 0);
    AT_DMA(AT_TILE(NT > 1 ? 1 : 0), 1);
    f32x16 o[4];
#pragma unroll
    for (int db = 0; db < 4; ++db)
#pragma unroll
        for (int i = 0; i < 16; ++i) o[db][i] = 0.f;
    float m_ref = -40.f, l_run = 0.f;
    const bool grpB = w >= 4;
#define AT_QK(kb, ks) do { const bf16x8 kf = *(const LAS bf16x8*)(Ks + (kb) * 8192 + (kbase0 ^ (32 * (ks)))); s[kb] = mfma32(kf, qf[ks], s[kb]); } while (0)
#define AT_PV(base, s2, pfrag) do { _Pragma("unroll") for (int db = 0; db < 4; ++db) { const bf16x8 vf = *(const LAS bf16x8*)((base) + db * 4096 + (vbase0 ^ (32 * (s2)))); o[db] = mfma32(vf, pfrag, o[db]); } asm volatile("" ::: "memory"); } while (0)
#define AT_SM1(kb, mxv) do { const unsigned wsh = ((kb) ? (unsigned)(mw >> 32) : (unsigned)mw) >> (4 * hh); mxv = -1e30f; \
            _Pragma("unroll") for (int i = 0; i < 16; ++i) { const bool sel = (wsh & (1u << ((i & 3) + 8 * (i >> 2)))) != 0u; s[kb][i] = sel ? s[kb][i] - m_ref : -1e30f; mxv = fmaxf(mxv, s[kb][i]); } \
            { auto rr = __builtin_amdgcn_permlane32_swap(__float_as_uint(mxv), __float_as_uint(mxv), false, false); mxv = fmaxf(__uint_as_float(rr[0]), __uint_as_float(rr[1])); } } while (0)
#define AT_RESC(kb, mxv) do { if (__any(mxv > 8.0f)) { const float dl = mxv > 8.0f ? mxv : 0.f; m_ref += dl; const float alpha = __builtin_amdgcn_exp2f(-dl); l_run *= alpha; \
            _Pragma("unroll") for (int i = 0; i < 16; ++i) s[kb][i] -= dl; \
            _Pragma("unroll") for (int db = 0; db < 4; ++db) _Pragma("unroll") for (int i = 0; i < 16; ++i) o[db][i] *= alpha; } } while (0)
#define AT_SM2(kb, pa, pb) do { float psum = 0.f; _Pragma("unroll") for (int i = 0; i < 16; ++i) { const float pv = __builtin_amdgcn_exp2f(s[kb][i]); s[kb][i] = pv; psum += pv; } l_run += psum; \
            u32x4 pw; pw.x = cvtpk(s[kb][0], s[kb][1]); pw.y = cvtpk(s[kb][2], s[kb][3]); pw.z = cvtpk(s[kb][4], s[kb][5]); pw.w = cvtpk(s[kb][6], s[kb][7]); pa = __builtin_bit_cast(bf16x8, pw); \
            pw.x = cvtpk(s[kb][8], s[kb][9]); pw.y = cvtpk(s[kb][10], s[kb][11]); pw.z = cvtpk(s[kb][12], s[kb][13]); pw.w = cvtpk(s[kb][14], s[kb][15]); pb = __builtin_bit_cast(bf16x8, pw); } while (0)
#define AT_PSCALE(pf, al) do { u32x4 pq = __builtin_bit_cast(u32x4, pf); _Pragma("unroll") for (int e = 0; e < 4; ++e) { \
            const float lo_ = __builtin_bit_cast(float, pq[e] << 16) * (al), hi_ = __builtin_bit_cast(float, pq[e] & 0xffff0000u) * (al); pq[e] = cvtpk(lo_, hi_); } pf = __builtin_bit_cast(bf16x8, pq); } while (0)
#define AT_HEAD() \
        asm volatile("s_waitcnt vmcnt(5) lgkmcnt(0)\n\ts_barrier" ::: "memory");    \
        const unsigned long long mw = *(const LAS unsigned long long*)(ldsb + ATT_MOFF + (t & 3) * 2048 + w * 256 + r32 * 8); \
        { const int tn = AT_TILE(t + 2 < NT ? t + 2 : NT - 1); AT_DMA(tn, ((t + 2) & 3)); }     \
        const LAS unsigned char* Ks = ldsb + (t & 3) * ATT_STAGE; \
        f32x16 s[2]; float mx0, mx1; \
        _Pragma("unroll") for (int i = 0; i < 16; ++i) { s[0][i] = 0.f; s[1][i] = 0.f; }
    if (!grpB) {
        for (int t = 0; t < NT; ++t) {
            AT_HEAD();
#pragma unroll
            for (int ks = 0; ks < 8; ++ks) AT_QK(0, ks);
            asm volatile("" ::: "memory");
#pragma unroll
            for (int ks = 0; ks < 8; ++ks) AT_QK(1, ks);
            asm volatile("" ::: "memory");
            bf16x8 p0a, p0b, p1a, p1b;
            AT_SM1(0, mx0);
            AT_RESC(0, mx0);
            AT_SM2(0, p0a, p0b);
            AT_PV(Ks, 0, p0a); AT_PV(Ks, 1, p0b);
            AT_SM1(1, mx1);
            AT_RESC(1, mx1);
            AT_SM2(1, p1a, p1b);
            AT_PV(Ks, 2, p1a); AT_PV(Ks, 3, p1b);
        }
    } else {
        bf16x8 p0a = {0, 0, 0, 0, 0, 0, 0, 0}, p0b = p0a, p1a = p0a, p1b = p0a;
        for (int t = 0; t < NT; ++t) {
            AT_HEAD();
            if (t > 0) { const LAS unsigned char* Kp = ldsb + ((t + 3) & 3) * ATT_STAGE; AT_PV(Kp, 0, p0a); AT_PV(Kp, 1, p0b); AT_PV(Kp, 2, p1a); AT_PV(Kp, 3, p1b); }
#pragma unroll
            for (int ks = 0; ks < 8; ++ks) AT_QK(0, ks);
            asm volatile("" ::: "memory");
#pragma unroll
            for (int ks = 0; ks < 8; ++ks) AT_QK(1, ks);
            asm volatile("" ::: "memory");
            AT_SM1(0, mx0);
            AT_RESC(0, mx0);
            AT_SM2(0, p0a, p0b);
            AT_SM1(1, mx1);
            if (__any(mx1 > 8.0f)) { const float al = __builtin_amdgcn_exp2f(-(mx1 > 8.0f ? mx1 : 0.f)); AT_PSCALE(p0a, al); AT_PSCALE(p0b, al); }
            AT_RESC(1, mx1);
            AT_SM2(1, p1a, p1b);
        }
        { const LAS unsigned char* Kp = ldsb + ((NT - 1) & 3) * ATT_STAGE; AT_PV(Kp, 0, p0a); AT_PV(Kp, 1, p0b); AT_PV(Kp, 2, p1a); AT_PV(Kp, 3, p1b); }
    }
#undef AT_HEAD
#undef AT_TILE
#undef AT_QK
#undef AT_PV
#undef AT_SM1
#undef AT_RESC
#undef AT_SM2
#undef AT_PSCALE
#undef AT_DMA
    asm volatile("s_waitcnt vmcnt(0)" ::: "memory");
    float l_tot; { auto rr = __builtin_amdgcn_permlane32_swap(__float_as_uint(l_run), __float_as_uint(l_run), false, false); l_tot = __uint_as_float(rr[0]) + __uint_as_float(rr[1]); }
    const float rl = 1.0f / l_tot;
    bf16_t* orow = (bf16_t*)(P.ws + OFF_O) + qrow * D + h * 128;
#pragma unroll
    for (int db = 0; db < 4; ++db)
#pragma unroll
        for (int i4 = 0; i4 < 4; ++i4) { u32x2 wv; wv.x = cvtpk(o[db][4 * i4] * rl, o[db][4 * i4 + 1] * rl); wv.y = cvtpk(o[db][4 * i4 + 2] * rl, o[db][4 * i4 + 3] * rl);
            *(u32x2*)(orow + 32 * db + 8 * i4 + 4 * hh) = wv; }
}


#define XB_TMO      128
#define XB_XCNT(j)  (256  + 64 * (j))
#define XB_XSUB(j)  (1280 + 64 * (j))
#define XB_XGEN(j)  (2304 + 64 * (j))
#define XB_TOP      3328
#define XB_TOPGEN   3392
#define XCD_BAR_WORDS 3456
#define XB_SPIN_CAP (1u << 18)
__device__ __forceinline__ unsigned xb_ld(unsigned* p)              { return __hip_atomic_load(p, __ATOMIC_RELAXED, __HIP_MEMORY_SCOPE_AGENT); }
__device__ __forceinline__ unsigned xb_add(unsigned* p, unsigned v) { return __hip_atomic_fetch_add(p, v, __ATOMIC_RELAXED, __HIP_MEMORY_SCOPE_AGENT); }
__device__ __forceinline__ unsigned xb_xcc_id() { return (unsigned)__builtin_amdgcn_s_getreg((3 << 11) | 20) & 0xFu; }
#define XB_SPIN(cond, bar) do { unsigned _sp = 0; while (cond) { __builtin_amdgcn_s_sleep(1); \
    if ((++_sp & 255u) == 0u) { if (xb_ld(&(bar)[XB_TMO])) break; if (_sp > XB_SPIN_CAP) { atomicAdd(&(bar)[XB_TMO], 1u); break; } } } } while (0)
struct XcdBarrier { unsigned* bar; unsigned x; volatile LAS unsigned* st; };
__device__ __forceinline__ XcdBarrier xcd_barrier_post(unsigned* bar, volatile LAS unsigned* st) {
    XcdBarrier b; b.bar = bar; b.x = xb_xcc_id(); b.st = st;
    if (threadIdx.x == 0) (void)xb_add(&bar[XB_XCNT(b.x)], 1u);
    return b;
}
__device__ __forceinline__ void xcd_barrier_complete(unsigned* bar, unsigned x, unsigned& nloc, unsigned& nx) {
    const unsigned G = gridDim.x * gridDim.y * gridDim.z;
    unsigned sum, cnt, mine, sp = 0u;
    for (;;) {
        sum = 0u; cnt = 0u; mine = 0u;
#pragma unroll
        for (unsigned j = 0; j < 16; ++j) { const unsigned c = xb_ld(&bar[XB_XCNT(j)]); sum += c; cnt += (c > 0u) ? 1u : 0u; mine = (j == x) ? c : mine; }
        if (sum == G) break;
        __builtin_amdgcn_s_sleep(1);
        if ((++sp & 255u) == 0u) { if (xb_ld(&bar[XB_TMO])) break; if (sp > XB_SPIN_CAP) { atomicAdd(&bar[XB_TMO], 1u); break; } }
    }
    nloc = mine > 0u ? mine : 1u; nx = cnt > 0u ? cnt : 1u;
}
__device__ __forceinline__ void xcd_barrier(const XcdBarrier& b) {
    asm volatile("s_waitcnt vmcnt(0)" ::: "memory");
    __syncthreads();
    if (threadIdx.x == 0) {
        unsigned* bar = b.bar;
        __builtin_amdgcn_s_waitcnt(0);
        unsigned nloc = b.st[0], nx = b.st[1];
        if (nloc == 0u) { xcd_barrier_complete(bar, b.x, nloc, nx); b.st[0] = nloc; b.st[1] = nx; }
        const unsigned old = xb_add(&bar[XB_XSUB(b.x)], 1u);
        const unsigned gen = old / nloc;
        if (old + 1u == (gen + 1u) * nloc) {
            __builtin_amdgcn_fence(__ATOMIC_RELEASE, "agent");
            asm volatile("s_waitcnt vmcnt(0)" ::: "memory");
            const unsigned og = xb_add(&bar[XB_TOP], 1u);
            const unsigned tg = og / nx;
            if (og + 1u == (tg + 1u) * nx) xb_add(&bar[XB_TOPGEN], 1u);
            else XB_SPIN(xb_ld(&bar[XB_TOPGEN]) == tg, bar);
            __builtin_amdgcn_fence(__ATOMIC_ACQUIRE, "agent");
            xb_add(&bar[XB_XGEN(b.x)], 1u);
            asm volatile("s_waitcnt vmcnt(0)" ::: "memory");
        } else {
            XB_SPIN(xb_ld(&bar[XB_XGEN(b.x)]) == gen, bar);
            __builtin_amdgcn_fence(__ATOMIC_ACQUIRE, "agent");
            asm volatile("s_waitcnt vmcnt(0)" ::: "memory");
        }
    }
    __syncthreads();
}
constexpr size_t OFF_STATS = 512 * 1024;
constexpr size_t OFF_BAR = 200 * 1024;
constexpr int LDS_BARST = LDS_BYTES - 64;

__global__ void __launch_bounds__(NTHR, 2) fwd_kernel(Params P) {
    extern __shared__ __attribute__((aligned(16))) unsigned char lds_raw[];
    LAS unsigned char* lds = (LAS unsigned char*)lds_raw;
    cg::grid_group grid = cg::this_grid();
    const int tid = threadIdx.x, lane = tid & 63, wave = tid >> 6; const int G = gridDim.x;
    unsigned char* ws = P.ws;
    const float* MOD = (const float*)(ws + OFF_MOD);
#define MODP(layer, idx) (MOD + ((size_t)(layer) * 2 * 6 + (idx)) * D)
    const int lo = P.ph_lo, hi = P.ph_hi;
    volatile LAS unsigned* xst = (volatile LAS unsigned*)(lds + LDS_BARST);
    if (tid < 2) xst[tid] = 0u;
    __syncthreads();
    XcdBarrier xbar; xbar.bar = (unsigned*)(ws + OFF_BAR); xbar.x = 0; xbar.st = xst;
    if (hi - lo > 1) xbar = xcd_barrier_post((unsigned*)(ws + OFF_BAR), xst);
    if (hi > 1000) grid.sync();
#ifndef PHMASK
#define PHMASK 0x1ffff
#endif
#define IN(k) (((PHMASK >> (k)) & 1) && lo <= (k) && (k) < hi)
#ifndef REPMASK
#define REPMASK 0
#endif
#define REPN(k) ((((REPMASK) >> (k)) & 1) ? 2 : 1)
#define SEAM(k) do { if (IN(k) && IN((k) + 1)) xcd_barrier(xbar); } while (0)

    if (IN(0)) for (int rep_ = 0; rep_ < REPN(0); ++rep_) {
        if (G == 256) { if (blockIdx.x < 128) s5_table_item(P, blockIdx.x, (LAS float*)lds);
                        else { mod_item(P, blockIdx.x - 128, (LAS float*)lds); if (blockIdx.x < 192) mod_item(P, blockIdx.x, (LAS float*)lds); } }
        else for (int it = blockIdx.x; it < 192 + 128; it += G) { if (it < 192) mod_item(P, it, (LAS float*)lds); else s5_table_item(P, it - 192, (LAS float*)lds); }
        __syncthreads();
        LAS float* scr = (LAS float*)(lds + wave * 16384);
        const int gw = blockIdx.x * NW + wave, NGW = G * NW;
        constexpr int I0 = 32 * 64, I1 = 32 * 128, I2 = 32 * 352, I4 = 88 * 64, I6 = 32 * 227, I7 = 32 * 64, IR = 256;
        constexpr int NIT = I0 + I1 + 2 * I2 + 2 * I4 + I6 + I7 + IR;
        for (int it = gw; it < NIT; it += NGW) {
            int r = it; const float* W; bf16_t* WT; int K_, N_, mode;
            if (r < I0) { W = P.s5_in_w; WT = (bf16_t*)(ws + OFF_W_S5IN); K_ = D; N_ = D; mode = 0; }
            else if ((r -= I0) < I1) { W = P.glu_w; WT = (bf16_t*)(ws + OFF_W_GLU); K_ = D; N_ = 2 * D; mode = 1; }
            else if ((r -= I1) < I2) { W = P.ffn_w_in; WT = (bf16_t*)(ws + OFF_W_FIN0); K_ = D; N_ = 2 * DFF; mode = 2; }
            else if ((r -= I2) < I2) { W = P.ffn_w_in + (size_t)D * 2 * DFF; WT = (bf16_t*)(ws + OFF_W_FIN1); K_ = D; N_ = 2 * DFF; mode = 2; }
            else if ((r -= I2) < I4) { W = P.ffn_w_out; WT = (bf16_t*)(ws + OFF_W_FOUT0); K_ = DFF; N_ = D; mode = 0; }
            else if ((r -= I4) < I4) { W = P.ffn_w_out + (size_t)DFF * D; WT = (bf16_t*)(ws + OFF_W_FOUT1); K_ = DFF; N_ = D; mode = 0; }
            else if ((r -= I4) < I6) { W = P.dsa_in_w; WT = (bf16_t*)(ws + OFF_W_DIN); K_ = D; N_ = DSA_IN; mode = 3; }
            else if ((r -= I6) < I7) { W = P.dsa_out_w; WT = (bf16_t*)(ws + OFF_W_DOUT); K_ = D; N_ = D; mode = 0; }
            else { r -= I7; rope_item(P, r, lane); continue; }
            transpose_item(W, K_, N_, WT, mode, scr, r, lane);
        }
        __syncthreads();
    }
    SEAM(0);
#ifdef EXTRA_SYNCS
    for (int e_ = 0; e_ < EXTRA_SYNCS; ++e_) grid.sync();
#endif
    if (IN(1)) for (int rep_ = 0; rep_ < REPN(1); ++rep_) row_pass<0>(P.x, nullptr, nullptr, MODP(0, 1), MODP(0, 0), nullptr, (bf16_t*)(ws + OFF_HB), G);
    SEAM(1);
    if (IN(2)) for (int rep_ = 0; rep_ < REPN(2); ++rep_) { pg8::Gemm g{(const bf16_t*)(ws + OFF_HB), (const bf16_t*)(ws + OFF_W_S5IN), M, D, D}; pg8::StaticOrder S; S.init(M, D, G, blockIdx.x);
        EpiU E{(bf16_t*)(ws + OFF_UG)}; pg8::gemm_phase(lds, g, S, E); }
    SEAM(2);
    if (IN(3)) for (int rep_ = 0; rep_ < REPN(3); ++rep_) { for (int it = blockIdx.x; it < 256; it += G) {
            int g = it >> 1, b = it & 1;
            if (G == 256) { const int x = it & 7, k = it >> 3, j = x + 8 * (k >> 3), sub = k & 7; g = 4 * j + (sub >> 1); b = sub & 1; }
            s5_item(P, g, b, lds); } }
    SEAM(3);
    if (IN(4)) for (int rep_ = 0; rep_ < REPN(4); ++rep_) { pg8::Gemm g{(const bf16_t*)(ws + OFF_G), (const bf16_t*)(ws + OFF_W_GLU), M, 2 * D, D}; pg8::StaticOrder S; S.init(M, 2 * D, G, blockIdx.x);
        EpiGLU E{P.glu_b, P.x, MODP(0, 2), (bf16_t*)(ws + OFF_V)}; pg8::gemm_phase(lds, g, S, E); }
    SEAM(4);
    if (IN(5)) for (int rep_ = 0; rep_ < REPN(5); ++rep_) row_pass<1>((const void*)(ws + OFF_V), P.ln_g, P.ln_b, MODP(0, 4), MODP(0, 3), (float*)(ws + OFF_STATS), (bf16_t*)(ws + OFF_HB), G);
    SEAM(5);
    if (IN(6)) for (int rep_ = 0; rep_ < REPN(6); ++rep_) { pg8::Gemm g{(const bf16_t*)(ws + OFF_HB), (const bf16_t*)(ws + OFF_W_FIN0), M, 2 * DFF, D}; pg8::StaticOrder S; S.init(M, 2 * DFF, G, blockIdx.x);
        EpiSwiGLU E{(bf16_t*)(ws + OFF_ACT)}; pg8::gemm_phase(lds, g, S, E); }
    SEAM(6);
    if (IN(7)) for (int rep_ = 0; rep_ < REPN(7); ++rep_) { pg8::Gemm g{(const bf16_t*)(ws + OFF_ACT), (const bf16_t*)(ws + OFF_W_FOUT0), M, D, DFF}; pg8::StaticOrder S; S.init(M, D, G, blockIdx.x);
        EpiRes E{(const bf16_t*)(ws + OFF_V), (const f32x2*)(ws + OFF_STATS), P.ln_g, P.ln_b, MODP(0, 5), (bf16_t*)(ws + OFF_X)}; pg8::gemm_phase(lds, g, S, E); }
    SEAM(7);
    if (IN(8)) for (int rep_ = 0; rep_ < REPN(8); ++rep_) row_pass<1>((const void*)(ws + OFF_X), P.ln_g + D, P.ln_b + D, MODP(1, 1), MODP(1, 0), (float*)(ws + OFF_STATS), (bf16_t*)(ws + OFF_HB), G);
    SEAM(8);
    if (IN(9)) for (int rep_ = 0; rep_ < REPN(9); ++rep_) { pg8::Gemm g{(const bf16_t*)(ws + OFF_HB), (const bf16_t*)(ws + OFF_W_DIN), M, DSA_NP, D}; pg8::StaticOrder S; S.init(M, DSA_NP, G, blockIdx.x);
        EpiDSA E{(bf16_t*)(ws + OFF_Q), (bf16_t*)(ws + OFF_K), (bf16_t*)(ws + OFF_VT), (bf16_t*)(ws + OFF_QI), (bf16_t*)(ws + OFF_KI), (float*)(ws + OFF_WI),
                 (const f32x2*)(ws + OFF_CSH), (const f32x2*)(ws + OFF_CSI)}; pg8::gemm_phase(lds, g, S, E); }
    SEAM(9);
    if (IN(10)) for (int rep_ = 0; rep_ < REPN(10); ++rep_) { for (int j = blockIdx.x; j < 1024; j += G) { const int b = j >> 9, jj = j & 511; const int blk = jj < 256 ? jj : 767 - jj; indexer_block(P, b, blk, lds); } }
    SEAM(10);
    if (IN(11)) for (int rep_ = 0; rep_ < REPN(11); ++rep_) {
        const int nu = (G == 256) ? 4 : (1024 - (int)blockIdx.x + G - 1) / G;
        for (int u = 0; u < nu; ++u) {
            int bh, qb; bool dsc;
            if (G == 256) { const int x = blockIdx.x & 7, li = blockIdx.x >> 3, gsel = li >> 4, p = li & 15; bh = x * 4 + 2 * (u >> 1) + gsel; dsc = (u & 1) != 0; qb = dsc ? 31 - p : p; }
            else { const int i = blockIdx.x + u * G; bh = i & 31; qb = 31 - (i >> 5); dsc = false; }
            attn_unit(P, bh >> 4, bh & 15, qb, dsc, lds);
        }
    }
    SEAM(11);
    if (IN(12)) for (int rep_ = 0; rep_ < REPN(12); ++rep_) { pg8::Gemm g{(const bf16_t*)(ws + OFF_O), (const bf16_t*)(ws + OFF_W_DOUT), M, D, D}; pg8::StaticOrder S; S.init(M, D, G, blockIdx.x);
        EpiRes E{(const bf16_t*)(ws + OFF_X), (const f32x2*)(ws + OFF_STATS), P.ln_g + D, P.ln_b + D, MODP(1, 2), (bf16_t*)(ws + OFF_V)}; pg8::gemm_phase(lds, g, S, E); }
    SEAM(12);
    if (IN(13)) for (int rep_ = 0; rep_ < REPN(13); ++rep_) row_pass<1>((const void*)(ws + OFF_V), P.ln_g + 2 * D, P.ln_b + 2 * D, MODP(1, 4), MODP(1, 3), (float*)(ws + OFF_STATS), (bf16_t*)(ws + OFF_HB), G);
    SEAM(13);
    if (IN(14)) for (int rep_ = 0; rep_ < REPN(14); ++rep_) { pg8::Gemm g{(const bf16_t*)(ws + OFF_HB), (const bf16_t*)(ws + OFF_W_FIN1), M, 2 * DFF, D}; pg8::StaticOrder S; S.init(M, 2 * DFF, G, blockIdx.x);
        EpiSwiGLU E{(bf16_t*)(ws + OFF_ACT)}; pg8::gemm_phase(lds, g, S, E); }
    SEAM(14);
    if (IN(15)) for (int rep_ = 0; rep_ < REPN(15); ++rep_) { pg8::Gemm g{(const bf16_t*)(ws + OFF_ACT), (const bf16_t*)(ws + OFF_W_FOUT1), M, D, DFF}; pg8::StaticOrder S; S.init(M, D, G, blockIdx.x);
        EpiRes E{(const bf16_t*)(ws + OFF_V), (const f32x2*)(ws + OFF_STATS), P.ln_g + 2 * D, P.ln_b + 2 * D, MODP(1, 5), (bf16_t*)(ws + OFF_X)}; pg8::gemm_phase(lds, g, S, E); }
    SEAM(15);
    if (IN(16)) for (int rep_ = 0; rep_ < REPN(16); ++rep_) row_pass<2>((const void*)(ws + OFF_X), P.ln_g + 3 * D, P.ln_b + 3 * D, nullptr, nullptr, P.out, nullptr, G);
#undef IN
#undef SEAM
#undef MODP
}

#ifndef MK_SPLIT
#define MK_SPLIT 0
#endif
constexpr int NPHASE = 17;

extern "C" void kernel_launch(void* const* d_in, const int* in_sizes, int n_in, void* d_out, int out_size, void* d_ws, size_t ws_size, hipStream_t stream) {
    static int grid = 0;
    if (grid == 0) {
        if (n_in != 22 || out_size != M * D || ws_size < WS_NEED) { fprintf(stderr, "kernel_launch: unexpected shapes (n_in %d out %d ws %zu)\n", n_in, out_size, ws_size); grid = -1; return; }
        int dev = 0, cus = 0, per_cu = 0;
        hipGetDevice(&dev); hipDeviceGetAttribute(&cus, hipDeviceAttributeMultiprocessorCount, dev);
        hipFuncSetAttribute((const void*)fwd_kernel, hipFuncAttributeMaxDynamicSharedMemorySize, LDS_BYTES);
        hipOccupancyMaxActiveBlocksPerMultiprocessor(&per_cu, (const void*)fwd_kernel, NTHR, LDS_BYTES);
        if (per_cu < 1) per_cu = 1;
        grid = cus * per_cu; if (grid > 256) grid = 256;
        (void)hipGetLastError();
    }
    if (grid < 0) return;
    Params p{};
    p.x = (const float*)d_in[0]; p.c = (const float*)d_in[1]; p.pos = (const int*)d_in[2]; p.ada_w = (const float*)d_in[3]; p.ada_b = (const float*)d_in[4];
    p.ln_g = (const float*)d_in[5]; p.ln_b = (const float*)d_in[6]; p.s5_in_w = (const float*)d_in[7]; p.a_re = (const float*)d_in[8]; p.a_im = (const float*)d_in[9];
    p.log_dt = (const float*)d_in[10]; p.b_re = (const float*)d_in[11]; p.b_im = (const float*)d_in[12]; p.c_re = (const float*)d_in[13]; p.c_im = (const float*)d_in[14];
    p.s5_d = (const float*)d_in[15]; p.glu_w = (const float*)d_in[16]; p.glu_b = (const float*)d_in[17]; p.dsa_in_w = (const float*)d_in[18]; p.dsa_out_w = (const float*)d_in[19];
    p.ffn_w_in = (const float*)d_in[20]; p.ffn_w_out = (const float*)d_in[21];
    p.out = (float*)d_out; p.ws = (unsigned char*)d_ws;
#if MK_SPLIT
    for (int ph = 0; ph < NPHASE; ++ph) { p.ph_lo = ph; p.ph_hi = ph + 1; hipLaunchKernelGGL(fwd_kernel, dim3(grid), dim3(NTHR), LDS_BYTES, stream, p); }
#else
    p.ph_lo = 0; p.ph_hi = NPHASE;
    (void)hipMemsetAsync((char*)d_ws + OFF_BAR, 0, 16384, stream);
    void* args[] = {&p};
    hipError_t e = hipLaunchCooperativeKernel((const void*)fwd_kernel, dim3(grid), dim3(NTHR), args, LDS_BYTES, stream);
    if (e != hipSuccess) fprintf(stderr, "cooperative launch failed: %s (grid %d)\n", hipGetErrorString(e), grid);
#endif
}
```

```cpp
#include <hip/hip_runtime.h>
#include <hip/hip_cooperative_groups.h>
#include <cstdio>
#include <cstdint>
namespace cg = cooperative_groups;

#define LAS __attribute__((address_space(3)))
typedef unsigned short bf16_t;
typedef short bf16x8 __attribute__((ext_vector_type(8)));
typedef float f32x4 __attribute__((ext_vector_type(4)));
typedef float f32x2 __attribute__((ext_vector_type(2)));
typedef float f32x16 __attribute__((ext_vector_type(16)));
typedef unsigned u32x4 __attribute__((ext_vector_type(4)));
typedef unsigned u32x2 __attribute__((ext_vector_type(2)));

constexpr int D = 2048, SEQ = 8192, M = 16384, DFF = 5632, DSA_IN = 7248, DSA_NP = 7424;
constexpr float ALPHA = 1.41421356237309515f, LN_EPS = 1e-5f;
constexpr float QSCALE = 0.08838834764831845f * 1.4426950408889634f;
constexpr int NTHR = 512, NW = 8;
constexpr int LDS_BYTES = 147456;
constexpr int CH_T = 32, NCH = SEQ / CH_T;
constexpr int ESTR = 132;

constexpr size_t MiB = 1u << 20;
constexpr size_t OFF_MOD = 0, OFF_LAMT = 256 * 1024, OFF_CSH = 1 * MiB, OFF_CSI = 9 * MiB, OFF_KM = 13 * MiB, OFF_WE = 15 * MiB, OFF_WP = 31 * MiB;
constexpr size_t OFF_W_S5IN = 47 * MiB, OFF_W_GLU = 55 * MiB, OFF_W_FIN0 = 71 * MiB, OFF_W_FIN1 = 115 * MiB, OFF_W_FOUT0 = 159 * MiB, OFF_W_FOUT1 = 181 * MiB;
constexpr size_t OFF_W_DIN = 203 * MiB, OFF_W_DOUT = 232 * MiB;
constexpr size_t OFF_X = 240 * MiB, OFF_V = 368 * MiB, OFF_HB = 496 * MiB, OFF_ACT = 560 * MiB;
constexpr size_t OFF_UG = 560 * MiB, OFF_G = 624 * MiB;
constexpr size_t OFF_Q = 560 * MiB, OFF_K = 624 * MiB, OFF_VT = 688 * MiB, OFF_KI = 752 * MiB, OFF_WI = 754 * MiB;
constexpr size_t OFF_QI = 368 * MiB, OFF_MASK = 400 * MiB, OFF_SCR = 416 * MiB;
constexpr size_t OFF_O = OFF_HB;
constexpr size_t WS_NEED = 756 * MiB;

struct Params {
    const float *x, *c; const int* pos; const float *ada_w, *ada_b, *ln_g, *ln_b, *s5_in_w, *a_re, *a_im, *log_dt, *b_re, *b_im, *c_re, *c_im, *s5_d,
        *glu_w, *glu_b, *dsa_in_w, *dsa_out_w, *ffn_w_in, *ffn_w_out;
    float* out; unsigned char* ws; int ph_lo, ph_hi;
};

__device__ __forceinline__ unsigned f2bf(float f) { unsigned u = __builtin_bit_cast(unsigned, f); return (u + 0x7fffu + ((u >> 16) & 1u)) >> 16; }
typedef __bf16 bf16x2_t __attribute__((ext_vector_type(2)));
__device__ __forceinline__ unsigned pk2(float lo, float hi) { f32x2 v = {lo, hi}; bf16x2_t b = __builtin_convertvector(v, bf16x2_t); return __builtin_bit_cast(unsigned, b); }
__device__ __forceinline__ float bf2f(unsigned short v) { return __builtin_bit_cast(float, ((unsigned)v) << 16); }
__device__ __forceinline__ float sigmoidf_(float v) { return __builtin_amdgcn_rcpf(1.0f + __expf(-v)); }
__device__ __forceinline__ f32x16 mfma32(bf16x8 a, bf16x8 b, f32x16 c) { return __builtin_amdgcn_mfma_f32_32x32x16_bf16(a, b, c, 0, 0, 0); }
__device__ __forceinline__ int crow(int r, int hi) { return (r & 3) + 8 * (r >> 2) + 4 * hi; }
__device__ __forceinline__ float wave_sum(float v) {
#pragma unroll
    for (int o = 1; o < 64; o <<= 1) v += __shfl_xor(v, o);
    return v;
}
__device__ __forceinline__ void sincos_rev(double rev, float& s, float& c) {
    double fr = rev - floor(rev); float f = (float)fr; s = __builtin_amdgcn_sinf(f); c = __builtin_amdgcn_cosf(f);
}

namespace pg8 {
constexpr int BM = 256, BK = 64, HALF = 128, HTB = HALF * BK * 2, STAGE_BYTES = 8 * HTB, NXCD = 8, WGM = 8;
__host__ __device__ __forceinline__ int lds_byte(int r, int c) { const int st = (r >> 4) * 2 + (c >> 5), rr = r & 15, cc = c & 31, ob = rr * 64 + cc * 2; return st * 1024 + (ob ^ (((ob >> 9) & 1) << 5)); }
__host__ __device__ __forceinline__ void stage_rc(int b, int& R, int& C) { const int st = b / 1024, sb = b % 1024, swz = sb ^ (((sb >> 9) & 1) << 5); R = (st >> 1) * 16 + swz / 64; C = (st & 1) * 32 + (swz % 64) / 2; }
__host__ __device__ __forceinline__ int perm32(int rho) { const int n = rho >> 4, i = rho & 15; return 8 * (i >> 2) + 4 * n + (i & 3); }
struct Unit { int pm, pn; };
struct Gemm { const bf16_t* A; const bf16_t* Bt; int M, N, K; };
struct StaticOrder {
    int nM, nN, nwg, G, c;
    __device__ void init(int M_, int N_, int G_, int c_) { nM = M_ / BM; nN = N_ / BM; nwg = nM * nN; G = G_; c = c_; }
    __device__ bool next(int i, Unit& u) const {
        const long L = (long)i * G + c; if (L >= nwg) return false;
        int wgid = (int)L; { const int q = nwg / NXCD, r = nwg % NXCD, xcd = wgid % NXCD, off = wgid / NXCD; wgid = (xcd < r ? xcd * (q + 1) : r * (q + 1) + (xcd - r) * q) + off; }
        const int nig = WGM * nN, gid = wgid / nig, fm = gid * WGM, gsz = (nM - fm) < WGM ? (nM - fm) : WGM;
        u.pm = fm + ((wgid % nig) % gsz); u.pn = (wgid % nig) / gsz; return true;
    }
};
__device__ __forceinline__ unsigned cvt_pk_bf16(float lo, float hi) { unsigned r; asm volatile("v_cvt_pk_bf16_f32 %0, %1, %2" : "=v"(r) : "v"(lo), "v"(hi)); return r; }

template <class Epi>
__device__ __forceinline__ void gemm_phase(LAS unsigned char* lds, const Gemm g, const StaticOrder& S, const Epi& E) {
    const int tid = threadIdx.x, wid = __builtin_amdgcn_readfirstlane(tid >> 6), lane = tid & 63, wr = wid >> 2, wc = wid & 3, fr = lane & 15, fq = lane >> 4;
    const int K = g.K, nt = K / BK;
    unsigned voffA[2], voffB[2];
#pragma unroll
    for (int i = 0; i < 2; ++i) { int R, C; stage_rc(tid * 16 + i * 8192, R, C); const int Rb = (R & ~31) + perm32(R & 31);
        voffA[i] = (unsigned)(R * K + C) * 2u; voffB[i] = (unsigned)(Rb * K + C) * 2u; }
    const size_t kstep = (size_t)(BK * 2);
    const size_t hstep = (size_t)HALF * K * 2;
    const size_t tstep = 2 * hstep;
    const unsigned ldsw = (unsigned)wid * 1024u;
    const int aoff = lds_byte(wr * 64 + fr, fq * 8), boff = lds_byte(wc * 32 + fr, fq * 8);
#define PG8_SA(b, h) (((b) * 2 + (h)) * HTB)
#define PG8_SB(b, h) ((4 + (b) * 2 + (h)) * HTB)
#define PG8_STAGE(bufoff, gbase, voff) do { _Pragma("unroll") for (int _i = 0; _i < 2; ++_i) \
        __builtin_amdgcn_global_load_lds((const unsigned*)((const char*)(gbase) + (voff)[_i]), (LAS unsigned*)(lds + (bufoff) + ldsw + _i * 8192), 16, 0, 0); } while (0)
#define PG8_LDA(dst, b, h) do { _Pragma("unroll") for (int m = 0; m < 4; ++m) _Pragma("unroll") for (int k = 0; k < 2; ++k) dst[m][k] = *(const LAS bf16x8*)(lds + PG8_SA(b, h) + aoff + m * 2048 + k * 1024); } while (0)
#define PG8_LDB(dst, b, h) do { _Pragma("unroll") for (int n = 0; n < 2; ++n) _Pragma("unroll") for (int k = 0; k < 2; ++k) dst[n][k] = *(const LAS bf16x8*)(lds + PG8_SB(b, h) + boff + n * 2048 + k * 1024); } while (0)
#define PG8_MMA(ai, bj, At, Bt) do { __builtin_amdgcn_s_setprio(1); _Pragma("unroll") for (int m = 0; m < 4; ++m) _Pragma("unroll") for (int n = 0; n < 2; ++n) _Pragma("unroll") for (int k = 0; k < 2; ++k) \
        acc[ai][bj][m][n] = __builtin_amdgcn_mfma_f32_16x16x32_bf16(Bt[n][k], At[m][k], acc[ai][bj][m][n], 0, 0, 0); __builtin_amdgcn_s_setprio(0); } while (0)
#define PG8_WAIT_V(n) asm volatile("s_waitcnt vmcnt(" #n ")" ::: "memory")
#define PG8_WAIT_L(n) asm volatile("s_waitcnt lgkmcnt(" #n ")" ::: "memory")
#define PG8_BAR __builtin_amdgcn_s_barrier()
#define PG8_SCHED __builtin_amdgcn_sched_barrier(0)
    Unit cur, nxt; int ui = 0;
    if (!S.next(0, cur)) return;
    f32x4 acc[2][2][4][2];
#pragma unroll
    for (int a = 0; a < 2; ++a)
#pragma unroll
        for (int b = 0; b < 2; ++b)
#pragma unroll
            for (int m = 0; m < 4; ++m)
#pragma unroll
                for (int n = 0; n < 2; ++n) acc[a][b][m][n] = (f32x4){0.f, 0.f, 0.f, 0.f};
    bf16x8 At[4][2], B0[2][2], B1[2][2];
    const char* cA = (const char*)g.A + (size_t)cur.pm * tstep; const char* cB = (const char*)g.Bt + (size_t)cur.pn * tstep;
    PG8_STAGE(PG8_SB(0, 0), cB, voffB); PG8_STAGE(PG8_SB(0, 1), cB + hstep, voffB); PG8_STAGE(PG8_SA(0, 0), cA, voffA); PG8_STAGE(PG8_SA(0, 1), cA + hstep, voffA);
    if (wr == 1) PG8_BAR;
    PG8_WAIT_V(2); PG8_BAR;
    PG8_STAGE(PG8_SB(1, 0), cB + kstep, voffB); PG8_STAGE(PG8_SA(1, 0), cA + kstep, voffA); PG8_STAGE(PG8_SB(1, 1), cB + hstep + kstep, voffB);
    PG8_WAIT_V(6); PG8_BAR;
    for (;;) {
        const bool has_next = S.next(ui + 1, nxt);
        const char* nA = has_next ? (const char*)g.A + (size_t)nxt.pm * tstep : cA; const char* nB = has_next ? (const char*)g.Bt + (size_t)nxt.pn * tstep : cB;
        for (int t = 0; t < nt; t += 2) {
            const bool last = (t == nt - 2);
            const char* a1 = cA + (size_t)(t + 1) * kstep;
            const char* a2 = last ? nA : cA + (size_t)(t + 2) * kstep; const char* b2 = last ? nB : cB + (size_t)(t + 2) * kstep;
            const char* a3 = a2 + kstep; const char* b3 = b2 + kstep;
            PG8_LDB(B0, 0, 0); PG8_LDB(B1, 0, 1); PG8_SCHED; PG8_LDA(At, 0, 0); PG8_STAGE(PG8_SA(1, 1), a1 + hstep, voffA);
            PG8_WAIT_V(8); PG8_WAIT_L(0); PG8_BAR; PG8_MMA(0, 0, At, B0); PG8_MMA(0, 1, At, B1); PG8_BAR; PG8_SCHED;
            PG8_LDA(At, 0, 1); PG8_STAGE(PG8_SB(0, 0), b2, voffB); PG8_STAGE(PG8_SB(0, 1), b2 + hstep, voffB); PG8_STAGE(PG8_SA(0, 0), a2, voffA);
            PG8_WAIT_V(8); PG8_WAIT_L(0); PG8_BAR; PG8_MMA(1, 0, At, B0); PG8_MMA(1, 1, At, B1); PG8_BAR; PG8_SCHED;
            PG8_LDB(B0, 1, 0); PG8_LDB(B1, 1, 1); PG8_SCHED; PG8_LDA(At, 1, 0); PG8_STAGE(PG8_SA(0, 1), a2 + hstep, voffA);
            PG8_WAIT_V(8); PG8_WAIT_L(0); PG8_BAR; PG8_MMA(0, 0, At, B0); PG8_MMA(0, 1, At, B1); PG8_BAR; PG8_SCHED;
            PG8_LDA(At, 1, 1); PG8_STAGE(PG8_SB(1, 0), b3, voffB); PG8_STAGE(PG8_SB(1, 1), b3 + hstep, voffB); PG8_STAGE(PG8_SA(1, 0), a3, voffA);
            PG8_WAIT_V(8); PG8_WAIT_L(0); PG8_BAR; PG8_MMA(1, 0, At, B0); PG8_MMA(1, 1, At, B1); PG8_BAR; PG8_SCHED;
        }
        if (wr == 0) PG8_BAR;
        E(acc, cur, wr, wc, fr, fq);
        if (!has_next) break;
#pragma unroll
        for (int a = 0; a < 2; ++a)
#pragma unroll
            for (int b = 0; b < 2; ++b)
#pragma unroll
                for (int m = 0; m < 4; ++m)
#pragma unroll
                    for (int n = 0; n < 2; ++n) acc[a][b][m][n] = (f32x4){0.f, 0.f, 0.f, 0.f};
        cur = nxt; cA = nA; cB = nB; ++ui;
        if (wr == 1) PG8_BAR;
    }
    PG8_WAIT_V(0);
    PG8_BAR;
#undef PG8_SA
#undef PG8_SB
#undef PG8_STAGE
#undef PG8_LDA
#undef PG8_LDB
#undef PG8_MMA
#undef PG8_WAIT_V
#undef PG8_WAIT_L
#undef PG8_BAR
#undef PG8_SCHED
}
}
typedef f32x4 Acc[2][2][4][2];

struct EpiU {
    bf16_t* Ug;
    __device__ __forceinline__ void operator()(const Acc& acc, const pg8::Unit& u, int wr, int wc, int fr, int fq) const {
#pragma unroll
        for (int ai = 0; ai < 2; ++ai)
#pragma unroll
            for (int m = 0; m < 4; ++m) { const int row = u.pm * 256 + ai * 128 + wr * 64 + m * 16 + fr;
#pragma unroll
                for (int bj = 0; bj < 2; ++bj) { const int c0 = u.pn * 256 + bj * 128 + wc * 32 + 8 * fq; const int g = c0 >> 4, half = (c0 >> 3) & 1;
                    const f32x4 v0 = acc[ai][bj][m][0], v1 = acc[ai][bj][m][1]; u32x4 w;
                    w.x = pk2(v0[0], v0[1]); w.y = pk2(v0[2], v0[3]); w.z = pk2(v1[0], v1[1]); w.w = pk2(v1[2], v1[3]);
                    *(u32x4*)(Ug + ((size_t)g * M + row) * 16 + half * 8) = w; } }
    }
};
struct EpiGLU {
    const float* bias; const float* xres; const float* gvec; bf16_t* V;
    __device__ __forceinline__ void operator()(const Acc& acc, const pg8::Unit& u, int wr, int wc, int fr, int fq) const {
        const int b = u.pm >= 32; const int p0 = u.pn * 128 + wc * 32 + 8 * fq;
        f32x4 bv[2], bg[2], gg[2];
#pragma unroll
        for (int n = 0; n < 2; ++n) { bv[n] = *(const f32x4*)(bias + p0 + 4 * n); bg[n] = *(const f32x4*)(bias + D + p0 + 4 * n); gg[n] = *(const f32x4*)(gvec + (size_t)b * 6 * D + p0 + 4 * n) + 1.0f; }
#pragma unroll
        for (int ai = 0; ai < 2; ++ai)
#pragma unroll
            for (int m = 0; m < 4; ++m) { const size_t row = u.pm * 256 + ai * 128 + wr * 64 + m * 16 + fr;
                float o[8];
#pragma unroll
                for (int n = 0; n < 2; ++n) { const f32x4 val = acc[ai][0][m][n] + bv[n], gate = acc[ai][1][m][n] + bg[n]; const f32x4 xv = *(const f32x4*)(xres + row * D + p0 + 4 * n);
#pragma unroll
                    for (int e = 0; e < 4; ++e) o[4 * n + e] = ALPHA * xv[e] + gg[n][e] * (val[e] * sigmoidf_(gate[e])); }
                u32x4 w; w.x = pk2(o[0], o[1]); w.y = pk2(o[2], o[3]); w.z = pk2(o[4], o[5]); w.w = pk2(o[6], o[7]);
                *(u32x4*)(V + row * D + p0) = w; }
    }
};
struct EpiSwiGLU {
    bf16_t* ACT;
    __device__ __forceinline__ void operator()(const Acc& acc, const pg8::Unit& u, int wr, int wc, int fr, int fq) const {
        const int p0 = u.pn * 128 + wc * 32 + 8 * fq;
#pragma unroll
        for (int ai = 0; ai < 2; ++ai)
#pragma unroll
            for (int m = 0; m < 4; ++m) { const size_t row = u.pm * 256 + ai * 128 + wr * 64 + m * 16 + fr; float o[8];
#pragma unroll
                for (int n = 0; n < 2; ++n)
#pragma unroll
                    for (int e = 0; e < 4; ++e) { const float gv = acc[ai][0][m][n][e], uv = acc[ai][1][m][n][e]; o[4 * n + e] = gv * sigmoidf_(gv) * uv; }
                u32x4 w; w.x = pk2(o[0], o[1]); w.y = pk2(o[2], o[3]); w.z = pk2(o[4], o[5]); w.w = pk2(o[6], o[7]);
                *(u32x4*)(ACT + row * DFF + p0) = w; }
    }
};
struct EpiRes {
    const bf16_t* Vprev; const f32x2* stats; const float* lg; const float* lb; const float* gvec; bf16_t* V;
    __device__ __forceinline__ void operator()(const Acc& acc, const pg8::Unit& u, int wr, int wc, int fr, int fq) const {
        const int b = u.pm >= 32;
#pragma unroll
        for (int bj = 0; bj < 2; ++bj) { const int c = u.pn * 256 + bj * 128 + wc * 32 + 8 * fq;
            f32x4 gg[2], g4[2], b4[2];
#pragma unroll
            for (int n = 0; n < 2; ++n) { gg[n] = *(const f32x4*)(gvec + (size_t)b * 6 * D + c + 4 * n) + 1.0f; g4[n] = *(const f32x4*)(lg + c + 4 * n); b4[n] = *(const f32x4*)(lb + c + 4 * n); }
#pragma unroll
            for (int ai = 0; ai < 2; ++ai)
#pragma unroll
                for (int m = 0; m < 4; ++m) { const size_t row = u.pm * 256 + ai * 128 + wr * 64 + m * 16 + fr; const f32x2 st = stats[row];
                    const u32x4 pv = *(const u32x4*)(Vprev + row * D + c); float o[8];
#pragma unroll
                    for (int n = 0; n < 2; ++n)
#pragma unroll
                        for (int e = 0; e < 4; ++e) { const unsigned wd = pv[2 * n + (e >> 1)]; const float vp = __builtin_bit_cast(float, (e & 1) ? (wd & 0xffff0000u) : (wd << 16));
                            const float xv = (vp - st.x) * st.y * g4[n][e] + b4[n][e]; o[4 * n + e] = xv * ALPHA + gg[n][e] * acc[ai][bj][m][n][e]; }
                    u32x4 w; w.x = pk2(o[0], o[1]); w.y = pk2(o[2], o[3]); w.z = pk2(o[4], o[5]); w.w = pk2(o[6], o[7]);
                    *(u32x4*)(V + row * D + c) = w; } }
    }
};
struct EpiDSA {
    bf16_t *Q, *K, *Vt, *QI, *KI; float* WI; const f32x2* CSH; const f32x2* CSI;
    __device__ __forceinline__ void operator()(const Acc& acc, const pg8::Unit& u, int wr, int wc, int fr, int fq) const {
        const int pn = u.pn;
        if (pn < 16) {
            const int pl = wc * 32 + 8 * fq, hh = pl >> 6, d0 = pl & 63, head = 2 * (pn & 7) + hh; bf16_t* dst = pn < 8 ? Q : K; const float sc = pn < 8 ? QSCALE : 1.0f;
#pragma unroll
            for (int ai = 0; ai < 2; ++ai)
#pragma unroll
                for (int m = 0; m < 4; ++m) { const size_t row = u.pm * 256 + ai * 128 + wr * 64 + m * 16 + fr; float o1[8], o2[8];
#pragma unroll
                    for (int n = 0; n < 2; ++n)
#pragma unroll
                        for (int e = 0; e < 4; ++e) { const f32x2 cs = CSH[row * 64 + d0 + 4 * n + e]; const float a = acc[ai][0][m][n][e], bb = acc[ai][1][m][n][e];
                            o1[4 * n + e] = (a * cs.x - bb * cs.y) * sc; o2[4 * n + e] = (bb * cs.x + a * cs.y) * sc; }
                    u32x4 w1, w2; w1.x = pk2(o1[0], o1[1]); w1.y = pk2(o1[2], o1[3]); w1.z = pk2(o1[4], o1[5]); w1.w = pk2(o1[6], o1[7]);
                    w2.x = pk2(o2[0], o2[1]); w2.y = pk2(o2[2], o2[3]); w2.z = pk2(o2[4], o2[5]); w2.w = pk2(o2[6], o2[7]);
                    bf16_t* p = dst + row * D + head * 128 + d0; *(u32x4*)p = w1; *(u32x4*)(p + 64) = w2; }
        } else if (pn < 24) {
#pragma unroll
            for (int ai = 0; ai < 2; ++ai)
#pragma unroll
                for (int m = 0; m < 4; ++m) { const int row = u.pm * 256 + ai * 128 + wr * 64 + m * 16 + fr; const int b = row >> 13, t = row & (SEQ - 1); const int tp = (t & ~15) | ((((t >> 2) & 1) << 1 | ((t >> 3) & 1)) << 2) | (t & 3);
#pragma unroll
                    for (int bj = 0; bj < 2; ++bj)
#pragma unroll
                        for (int n = 0; n < 2; ++n)
#pragma unroll
                            for (int e = 0; e < 4; ++e) { const int c = (pn - 16) * 256 + bj * 128 + wc * 32 + 8 * fq + 4 * n + e; const int head = c >> 7, d = c & 127;
                                Vt[((size_t)((b * 16 + head) * 128 + d)) * SEQ + tp] = (bf16_t)f2bf(acc[ai][bj][m][n][e]); } }
        } else if (pn < 28) {
            const int ih = 4 * (pn - 24) + wc, d0 = 8 * fq;
#pragma unroll
            for (int ai = 0; ai < 2; ++ai)
#pragma unroll
                for (int m = 0; m < 4; ++m) { const size_t row = u.pm * 256 + ai * 128 + wr * 64 + m * 16 + fr; float o1[8], o2[8];
#pragma unroll
                    for (int n = 0; n < 2; ++n)
#pragma unroll
                        for (int e = 0; e < 4; ++e) { const f32x2 cs = CSI[row * 32 + d0 + 4 * n + e]; const float a = acc[ai][0][m][n][e], bb = acc[ai][1][m][n][e];
                            o1[4 * n + e] = (a * cs.x - bb * cs.y) * 0.125f; o2[4 * n + e] = (bb * cs.x + a * cs.y) * 0.125f; }
                    u32x4 w1, w2; w1.x = pk2(o1[0], o1[1]); w1.y = pk2(o1[2], o1[3]); w1.z = pk2(o1[4], o1[5]); w1.w = pk2(o1[6], o1[7]);
                    w2.x = pk2(o2[0], o2[1]); w2.y = pk2(o2[2], o2[3]); w2.z = pk2(o2[4], o2[5]); w2.w = pk2(o2[6], o2[7]);
                    bf16_t* p = QI + row * 1024 + ih * 64 + d0; *(u32x4*)p = w1; *(u32x4*)(p + 32) = w2; }
        } else {
            if (wc == 0) {
                const int d0 = 8 * fq;
#pragma unroll
                for (int ai = 0; ai < 2; ++ai)
#pragma unroll
                    for (int m = 0; m < 4; ++m) { const size_t row = u.pm * 256 + ai * 128 + wr * 64 + m * 16 + fr; float o1[8], o2[8];
#pragma unroll
                        for (int n = 0; n < 2; ++n)
#pragma unroll
                            for (int e = 0; e < 4; ++e) { const f32x2 cs = CSI[row * 32 + d0 + 4 * n + e]; const float a = acc[ai][0][m][n][e], bb = acc[ai][1][m][n][e];
                                o1[4 * n + e] = a * cs.x - bb * cs.y; o2[4 * n + e] = bb * cs.x + a * cs.y; }
                        u32x4 w1, w2; w1.x = pk2(o1[0], o1[1]); w1.y = pk2(o1[2], o1[3]); w1.z = pk2(o1[4], o1[5]); w1.w = pk2(o1[6], o1[7]);
                        w2.x = pk2(o2[0], o2[1]); w2.y = pk2(o2[2], o2[3]); w2.z = pk2(o2[4], o2[5]); w2.w = pk2(o2[6], o2[7]);
                        bf16_t* p = KI + row * 64 + d0; *(u32x4*)p = w1; *(u32x4*)(p + 32) = w2; }
            } else if (wc == 1 && fq < 2) {
#pragma unroll
                for (int ai = 0; ai < 2; ++ai)
#pragma unroll
                    for (int m = 0; m < 4; ++m) { const size_t row = u.pm * 256 + ai * 128 + wr * 64 + m * 16 + fr;
#pragma unroll
                        for (int n = 0; n < 2; ++n) *(f32x4*)(WI + row * 16 + 8 * fq + 4 * n) = acc[ai][0][m][n] * 0.25f; }
            }
        }
    }
};

__device__ __forceinline__ int dest_row(int mode, int n) {
    if (mode == 0) return n;
    if (mode == 1) { const int s = n >= 2048, p = n - s * 2048; return 256 * (p >> 7) + 128 * s + (p & 127); }
    if (mode == 2) { const int s = n >= DFF, p = n - s * DFF; return 256 * (p >> 7) + 128 * s + (p & 127); }
    if (n < 4096) { const int blk = n >> 11, w = n & 2047, head = w >> 7, e = w & 127, s = e >> 6, d = e & 63; return blk * 2048 + 256 * (head >> 1) + 128 * s + 64 * (head & 1) + d; }
    if (n < 6144) return n;
    if (n < 7168) { const int mm = n - 6144, ih = mm >> 6, e = mm & 63, s = e >> 5, d = e & 31; return 6144 + 256 * (ih >> 2) + 128 * s + 32 * (ih & 3) + d; }
    if (n < 7184) return 7168 + 32 + (n - 7168);
    { const int mm = n - 7184, s = mm >> 5, d = mm & 31; return 7168 + 128 * s + d; }
}
__device__ __forceinline__ void transpose_item(const float* W, int K, int N, bf16_t* WT, int mode, LAS float* scr, int item, int lane) {
    const int nblk = (N + 31) / 32, kb = item / nblk, nb = item % nblk, k0 = 64 * kb, n0 = 32 * nb;
    const int nn = n0 + (lane & 31); const bool okn = nn < N;
    float tv[32];
#pragma unroll
    for (int i = 0; i < 32; ++i) { const int kk = 2 * i + (lane >> 5); tv[i] = okn ? W[(size_t)(k0 + kk) * N + nn] : 0.f; }
#pragma unroll
    for (int i = 0; i < 32; ++i) { const int kk = 2 * i + (lane >> 5); scr[kk * 33 + (lane & 31)] = tv[i]; }
    asm volatile("s_waitcnt lgkmcnt(0)" ::: "memory");
    const int c = lane & 7;
#pragma unroll
    for (int j = 0; j < 4; ++j) { const int n = (lane >> 3) + 8 * j; const LAS float* s = scr + (8 * c) * 33 + n;
        u32x4 o; o.x = pk2(s[0 * 33], s[1 * 33]); o.y = pk2(s[2 * 33], s[3 * 33]); o.z = pk2(s[4 * 33], s[5 * 33]); o.w = pk2(s[6 * 33], s[7 * 33]);
        if (n0 + n < N) *(u32x4*)(WT + (size_t)dest_row(mode, n0 + n) * K + k0 + 8 * c) = o; }
    asm volatile("s_waitcnt lgkmcnt(0)" ::: "memory");
}

__device__ __forceinline__ void mod_item(const Params& P, int item, LAS float* lds) {
    const int tid = threadIdx.x; const int layer = item / 96, cb = item % 96;
    LAS float* cact = lds;
    LAS float* red = lds + 4096;
    for (int i = tid; i < 2 * D; i += NTHR) { const float v = P.c[i]; cact[i] = v * sigmoidf_(v); }
    __syncthreads();
    const int cq = tid & 31, ks = tid >> 5; const int col = cb * 128 + cq * 4;
    const float* W = P.ada_w + (size_t)layer * D * 6 * D + col;
    f32x4 a0 = {0.f, 0.f, 0.f, 0.f}, a1 = {0.f, 0.f, 0.f, 0.f};
#pragma unroll 16
    for (int k = ks * 128; k < ks * 128 + 128; ++k) { const f32x4 w = *(const f32x4*)(W + (size_t)k * 6 * D); a0 += w * cact[k]; a1 += w * cact[D + k]; }
    *(LAS f32x4*)(red + (ks * 2 + 0) * 128 + cq * 4) = a0; *(LAS f32x4*)(red + (ks * 2 + 1) * 128 + cq * 4) = a1;
    __syncthreads();
    if (tid < 256) { const int b = tid >> 7, cc = tid & 127; float s = P.ada_b[layer * 6 * D + cb * 128 + cc];
#pragma unroll
        for (int k = 0; k < 16; ++k) s += red[(k * 2 + b) * 128 + cc];
        ((float*)(P.ws + OFF_MOD))[(size_t)(layer * 2 + b) * 6 * D + cb * 128 + cc] = s; }
    __syncthreads();
}

__device__ __forceinline__ void s5_table_item(const Params& P, int g, LAS float* lds) {
    const int tid = threadIdx.x;
    LAS f32x2* pw = (LAS f32x2*)lds;
    LAS f32x2* bb = pw + 33 * 64;
    LAS f32x2* cc = bb + 64 * 16;
    {
        const double dt = exp((double)P.log_dt[g]);
#pragma unroll 1
        for (int idx = tid; idx < 33 * 64; idx += NTHR) { const int k = idx >> 6, n = idx & 63;
            const double zre = (double)P.a_re[g * 64 + n] * dt, zim = (double)P.a_im[g * 64 + n] * dt;
            const float mag = (float)exp(zre * k); float sn, cs; sincos_rev(zim * k * 0.15915494309189535, sn, cs); pw[k * 64 + n] = (f32x2){mag * cs, mag * sn}; }
    }
    __syncthreads();
#pragma unroll 1
    for (int i = tid; i < 64 * 16; i += NTHR) { const int n = i >> 4;
        const float are = P.a_re[g * 64 + n], aim = P.a_im[g * 64 + n]; const f32x2 lb = pw[64 + n];
        const float nr = lb.x - 1.0f, ni = lb.y, den = are * are + aim * aim;
        const float fr_ = (nr * are + ni * aim) / den, fi_ = (ni * are - nr * aim) / den;
        const float br = P.b_re[(size_t)g * 1024 + i], bi = P.b_im[(size_t)g * 1024 + i];
        bb[i] = (f32x2){fr_ * br - fi_ * bi, fr_ * bi + fi_ * br};
        cc[i] = (f32x2){P.c_re[(size_t)g * 1024 + i], P.c_im[(size_t)g * 1024 + i]}; }
    __syncthreads();
    bf16_t* WE = (bf16_t*)(P.ws + OFF_WE) + (size_t)g * 128 * 512;
    bf16_t* WP = (bf16_t*)(P.ws + OFF_WP) + (size_t)g * 512 * 128;
    bf16_t* KM = (bf16_t*)(P.ws + OFF_KM) + (size_t)g * 32 * 256;
#pragma unroll 2
    for (int idx = tid; idx < 128 * 512; idx += NTHR) { const int np = idx >> 9, jp = idx & 511, j = jp >> 4, p = jp & 15, n = np & 63;
        const f32x2 l = pw[(31 - j) * 64 + n], b = bb[n * 16 + p]; const float re = l.x * b.x - l.y * b.y, im = l.x * b.y + l.y * b.x;
        WE[idx] = (bf16_t)f2bf(np < 64 ? re : im); }
#pragma unroll 2
    for (int idx = tid; idx < 512 * 128; idx += NTHR) { const int jp = idx >> 7, np = idx & 127, j = jp >> 4, p = jp & 15, n = np & 63;
        const f32x2 l = pw[(j + 1) * 64 + n], c = cc[p * 64 + n]; const float re = l.x * c.x - l.y * c.y, im = l.x * c.y + l.y * c.x;
        WP[idx] = (bf16_t)f2bf(np < 64 ? re : -im); }
#pragma unroll 1
    for (int idx = tid; idx < 32 * 256; idx += NTHR) { const int tau = idx >> 8, p = (idx >> 4) & 15, q = idx & 15; float s = 0.f;
#pragma unroll 4
        for (int n = 0; n < 64; ++n) { const f32x2 l = pw[tau * 64 + n], c = cc[p * 64 + n], b = bb[n * 16 + q];
            const float tr = c.x * l.x - c.y * l.y, ti = c.x * l.y + c.y * l.x; s += tr * b.x - ti * b.y; }
        KM[idx] = (bf16_t)f2bf(s); }
    if (tid < 64) ((f32x2*)(P.ws + OFF_LAMT))[g * 64 + tid] = pw[32 * 64 + tid];
    __syncthreads();
}

__device__ __forceinline__ void rope_item(const Params& P, int item, int lane) {
    f32x2* CSH = (f32x2*)(P.ws + OFF_CSH); f32x2* CSI = (f32x2*)(P.ws + OFF_CSI);
    const float invh = 1.0f / powf(10000.0f, (float)(2 * lane) / 128.0f);
    const float invi = 1.0f / powf(10000.0f, (float)(2 * (lane & 31)) / 64.0f);
    for (int r = 0; r < 64; ++r) { const int row = item * 64 + r; const float pos = (float)P.pos[row];
        { const float ang = pos * invh; float s, c; sincos_rev((double)ang * 0.15915494309189535, s, c); CSH[(size_t)row * 64 + lane] = (f32x2){c, s}; }
        if (lane < 32) { const float ang = pos * invi; float s, c; sincos_rev((double)ang * 0.15915494309189535, s, c); CSI[(size_t)row * 32 + lane] = (f32x2){c, s}; } }
}

template <int MODE>
__device__ __forceinline__ void row_pass(const void* src, const float* lg, const float* lb, const float* sc, const float* sh, float* Xout, bf16_t* HB, int G) {
    const int lane = threadIdx.x & 63, wave = threadIdx.x >> 6; const int gw = blockIdx.x * NW + wave, NGW = G * NW;
    for (int m = gw; m < M; m += NGW) {
        const int b = m >> 13;
        f32x4 v[8];
        if (MODE == 0) { const f32x4* xr = (const f32x4*)((const float*)src + (size_t)m * D) + lane;
#pragma unroll
            for (int j = 0; j < 8; ++j) v[j] = xr[64 * j]; }
        else { const u32x4* xr = (const u32x4*)((const bf16_t*)src + (size_t)m * D) + lane;
#pragma unroll
            for (int j = 0; j < 4; ++j) { const u32x4 p = xr[64 * j];
                v[2 * j] = (f32x4){__builtin_bit_cast(float, p.x << 16), __builtin_bit_cast(float, p.x & 0xffff0000u), __builtin_bit_cast(float, p.y << 16), __builtin_bit_cast(float, p.y & 0xffff0000u)};
                v[2 * j + 1] = (f32x4){__builtin_bit_cast(float, p.z << 16), __builtin_bit_cast(float, p.z & 0xffff0000u), __builtin_bit_cast(float, p.w << 16), __builtin_bit_cast(float, p.w & 0xffff0000u)}; } }
#define RP_IDX(j) (MODE == 0 ? (lane + 64 * (j)) : (2 * (lane + 64 * ((j) >> 1)) + ((j) & 1)))
        if (MODE != 0) {
            float s = 0.f;
#pragma unroll
            for (int j = 0; j < 8; ++j) s += (v[j].x + v[j].y) + (v[j].z + v[j].w);
            const float mean = wave_sum(s) * (1.f / D); float s2 = 0.f;
#pragma unroll
            for (int j = 0; j < 8; ++j) { v[j] = v[j] - mean; s2 += (v[j].x * v[j].x + v[j].y * v[j].y) + (v[j].z * v[j].z + v[j].w * v[j].w); }
            const float rstd = 1.f / sqrtf(wave_sum(s2) * (1.f / D) + LN_EPS);
#pragma unroll
            for (int j = 0; j < 8; ++j) { const f32x4 gg = *((const f32x4*)lg + RP_IDX(j)), bb = *((const f32x4*)lb + RP_IDX(j)); v[j] = v[j] * rstd * gg + bb;
                if (MODE == 2) *((f32x4*)(Xout + (size_t)m * D) + RP_IDX(j)) = v[j]; }
            if (MODE == 1 && lane == 0) ((f32x2*)Xout)[m] = (f32x2){mean, rstd};
        }
        if (MODE != 2) {
#pragma unroll
            for (int j = 0; j < 8; ++j) { const f32x4 s1 = *((const f32x4*)(sc + (size_t)b * 6 * D) + RP_IDX(j)) + 1.0f, s0 = *((const f32x4*)(sh + (size_t)b * 6 * D) + RP_IDX(j));
                const f32x4 h = v[j] * s1 + s0; u32x2 w; w.x = pk2(h.x, h.y); w.y = pk2(h.z, h.w);
                *((u32x2*)(HB + (size_t)m * D) + RP_IDX(j)) = w; }
        }
#undef RP_IDX
    }
}

__device__ __forceinline__ float gelu_tanh(float x) { const float z = 0.7978845608028654f * (x + 0.044715f * x * x * x); return x * __builtin_amdgcn_rcpf(1.0f + __expf(-2.0f * z)); }
__device__ __forceinline__ void s5_item(const Params& P, int g, int b, LAS unsigned char* ldsb) {
    const int tid = threadIdx.x, lane = tid & 63, w = tid >> 6, r32 = lane & 31, hh = lane >> 5;
    LAS float* E = (LAS float*)ldsb;
    const bf16_t* Ug = (const bf16_t*)(P.ws + OFF_UG) + ((size_t)g * M + (size_t)b * SEQ) * 16;
    const bf16_t* WE = (const bf16_t*)(P.ws + OFF_WE) + (size_t)g * 128 * 512;
    const bf16_t* WP = (const bf16_t*)(P.ws + OFF_WP) + (size_t)g * 512 * 128;
    const bf16_t* KM = (const bf16_t*)(P.ws + OFF_KM) + (size_t)g * 32 * 256;
    bf16_t* Gout = (bf16_t*)(P.ws + OFF_G);
    const int c = 32 * w + r32;
    const bf16_t* ucol = Ug + (size_t)c * CH_T * 16 + 8 * hh;
    {
        f32x16 acc[4];
#pragma unroll
        for (int rb = 0; rb < 4; ++rb)
#pragma unroll
            for (int i = 0; i < 16; ++i) acc[rb][i] = 0.f;
#pragma unroll 4
        for (int ks = 0; ks < 32; ++ks) {
            const bf16x8 bf = *(const bf16x8*)(ucol + ks * 16);
#pragma unroll
            for (int rb = 0; rb < 4; ++rb) { const bf16x8 af = *(const bf16x8*)(WE + (size_t)(32 * rb + r32) * 512 + 16 * ks + 8 * hh); acc[rb] = mfma32(af, bf, acc[rb]); }
        }
#pragma unroll
        for (int rb = 0; rb < 4; ++rb)
#pragma unroll
            for (int i = 0; i < 4; ++i) *(LAS f32x4*)(E + c * ESTR + 32 * rb + 8 * i + 4 * hh) = (f32x4){acc[rb][4 * i], acc[rb][4 * i + 1], acc[rb][4 * i + 2], acc[rb][4 * i + 3]};
    }
    __syncthreads();
    if (w == 0) {
        const f32x2 lt = ((const f32x2*)(P.ws + OFF_LAMT))[g * 64 + lane]; float sr = 0.f, si = 0.f;
        for (int cc = 0; cc < NCH; ++cc) {
            const float er = E[cc * ESTR + lane], ei = E[cc * ESTR + 64 + lane];
            __builtin_amdgcn_wave_barrier();
            LAS bf16_t* pp = (LAS bf16_t*)(E + cc * ESTR); pp[lane] = (bf16_t)f2bf(sr); pp[64 + lane] = (bf16_t)f2bf(si);
            const float nr = lt.x * sr - lt.y * si + er, ni = lt.x * si + lt.y * sr + ei; sr = nr; si = ni;
        }
    }
    __syncthreads();
    {
        bf16x8 pf[8];
#pragma unroll
        for (int ks = 0; ks < 8; ++ks) pf[ks] = *(const LAS bf16x8*)((LAS unsigned char*)(E + c * ESTR) + 32 * ks + 16 * hh);
        const int jr = r32 >> 4, pr = r32 & 15;
        for (int Jg = 0; Jg < 4; ++Jg) {
            f32x16 acc[4];
#pragma unroll
            for (int jb = 0; jb < 4; ++jb)
#pragma unroll
                for (int i = 0; i < 16; ++i) acc[jb][i] = 0.f;
#pragma unroll
            for (int jb = 0; jb < 4; ++jb) { const int J = 4 * Jg + jb;
#pragma unroll
                for (int ks = 0; ks < 8; ++ks) { const bf16x8 af = *(const bf16x8*)(WP + (size_t)(32 * J + r32) * 128 + 16 * ks + 8 * hh); acc[jb] = mfma32(af, pf[ks], acc[jb]); } }
            const int imax = 8 * Jg + 7;
            for (int i = 0; i <= imax; ++i) {
                const bf16x8 bf = *(const bf16x8*)(ucol + i * 16);
#pragma unroll
                for (int jb = 0; jb < 4; ++jb) { const int J = 4 * Jg + jb;
                    if (i <= 2 * J + 1) { const int tau = 2 * J + jr - i; bf16x8 af = {0, 0, 0, 0, 0, 0, 0, 0};
                        if (tau >= 0) af = *(const bf16x8*)(KM + (size_t)tau * 256 + pr * 16 + 8 * hh);
                        acc[jb] = mfma32(af, bf, acc[jb]); } }
            }
#pragma unroll
            for (int jb = 0; jb < 4; ++jb) { const int J = 4 * Jg + jb;
#pragma unroll
                for (int i4 = 0; i4 < 4; ++i4) { const int jj = i4 >> 1, p0 = 8 * (i4 & 1) + 4 * hh; const int tok = c * CH_T + 2 * J + jj; const int ch0 = g * 16 + p0;
                    const u32x2 uu = *(const u32x2*)(Ug + (size_t)tok * 16 + p0); const f32x4 dsk = *(const f32x4*)(P.s5_d + ch0);
                    const float u0 = __builtin_bit_cast(float, uu.x << 16), u1 = __builtin_bit_cast(float, uu.x & 0xffff0000u), u2 = __builtin_bit_cast(float, uu.y << 16), u3 = __builtin_bit_cast(float, uu.y & 0xffff0000u);
                    const float y0 = gelu_tanh(acc[jb][4 * i4] + dsk.x * u0), y1 = gelu_tanh(acc[jb][4 * i4 + 1] + dsk.y * u1), y2 = gelu_tanh(acc[jb][4 * i4 + 2] + dsk.z * u2), y3 = gelu_tanh(acc[jb][4 * i4 + 3] + dsk.w * u3);
                    u32x2 o; o.x = pk2(y0, y1); o.y = pk2(y2, y3);
                    *(u32x2*)(Gout + ((size_t)b * SEQ + tok) * D + ch0) = o; } }
        }
    }
    __syncthreads();
}

__device__ __forceinline__ unsigned ordkey(float f) { const unsigned u = __builtin_bit_cast(unsigned, f); return (u & 0x80000000u) ? ~u : (u | 0x80000000u); }
#define LDS_ADD1(p) ((void)__hip_atomic_fetch_add((p), 1u, __ATOMIC_RELAXED, __HIP_MEMORY_SCOPE_WORKGROUP))
template <int NB>
__device__ __forceinline__ void radix_pass(const float* s, int n, int nch, int shift, int hshift, unsigned hval, LAS unsigned* hist, int lane, unsigned& K, unsigned& binout) {
    constexpr int BPL = NB / 64;
#pragma unroll
    for (int j = 0; j < BPL; ++j) hist[lane + 64 * j] = 0u;
    __builtin_amdgcn_wave_barrier();
#pragma unroll 1
    for (int base = 0; base < nch; base += 16) {
        float v[16];
#pragma unroll
        for (int j = 0; j < 16; ++j) { const int i = 64 * (base + j) + lane; v[j] = (i < n) ? s[i] : __builtin_nanf(""); }
#pragma unroll
        for (int j = 0; j < 16; ++j) { const int i = 64 * (base + j) + lane; const unsigned kk = ordkey(v[j]); const bool ok = (i < n) && ((hshift >= 32) || ((kk >> hshift) == hval));
            if (ok) LDS_ADD1(hist + ((kk >> shift) & (NB - 1))); }
    }
    __builtin_amdgcn_wave_barrier();
    asm volatile("s_waitcnt lgkmcnt(0)" ::: "memory");
    unsigned sl = 0;
#pragma unroll
    for (int j = 0; j < BPL; ++j) sl += hist[lane * BPL + j];
    unsigned inc = sl;
#pragma unroll
    for (int off = 1; off < 64; off <<= 1) { const unsigned t = __shfl_down(inc, off); if (lane + off < 64) inc += t; }
    const unsigned above = inc - sl;
    const bool mine = (above < K) && (K <= inc);
    unsigned bin = 0, krem = 0;
    if (mine) { unsigned cum = above; bool found = false;
        for (int j = BPL - 1; j >= 0; --j) { const unsigned cnt = hist[lane * BPL + j]; if (!found && cum + cnt >= K) { found = true; bin = lane * BPL + j; krem = K - cum; } cum += cnt; } }
    const unsigned long long bm = __ballot(mine); const int src = bm ? (__ffsll((long long)bm) - 1) : 0;
    binout = __shfl(bin, src); K = __shfl(krem, src);
    __builtin_amdgcn_wave_barrier();
}
__device__ __forceinline__ void select_query(const float* s, int b, int t, LAS unsigned* hist, int lane, unsigned long long* MASK) {
    const int n = t + 1; const int nch_tot = ((t >> 8) + 1) * 4; const int nch = (n + 63) >> 6;
    unsigned long long* mp = MASK + (size_t)b * 128 * SEQ + t;
    if (n <= 256) {
        for (int ch = 0; ch < nch_tot; ++ch) { const int i = 64 * ch + lane; const unsigned long long wd = __ballot(i < n); if (lane == 0) mp[(size_t)ch * SEQ] = wd; }
        return;
    }
    unsigned K = 256, b1, b2, b3;
    radix_pass<2048>(s, n, nch, 21, 32, 0u, hist, lane, K, b1);
    radix_pass<2048>(s, n, nch, 10, 21, b1, hist, lane, K, b2);
    radix_pass<1024>(s, n, nch, 0, 10, (b1 << 11) | b2, hist, lane, K, b3);
    const unsigned T = (b1 << 21) | (b2 << 10) | b3; unsigned running = 0;
#pragma unroll 1
    for (int base = 0; base < nch_tot; base += 16) {
        float v[16];
#pragma unroll
        for (int j = 0; j < 16; ++j) { const int i = 64 * (base + j) + lane; v[j] = (i < n) ? s[i] : __builtin_nanf(""); }
#pragma unroll
        for (int j = 0; j < 16; ++j) { const int i = 64 * (base + j) + lane; const unsigned kk = ordkey(v[j]); const bool valid = i < n;
            const bool gt = valid && kk > T, eq = valid && kk == T; const unsigned long long em = __ballot(eq);
            const unsigned rank = running + (unsigned)__popcll(em & ((1ull << lane) - 1ull));
            const unsigned long long wd = __ballot(gt || (eq && rank < K)); if (lane == 0 && base + j < nch_tot) mp[(size_t)(base + j) * SEQ] = wd; running += (unsigned)__popcll(em); }
    }
}
constexpr int IX_SK = 256, IX_RSTR = 144, IX_STAGE = IX_SK * IX_RSTR;
__device__ __forceinline__ float relu_asm(float x) { return __builtin_amdgcn_fmed3f(x, 0.f, __builtin_inff()); }
__device__ __forceinline__ void indexer_block(const Params& P, int b, int blk, LAS unsigned char* ldsb) {
    const int tid = threadIdx.x, lane = tid & 63, w = tid >> 6, r32 = lane & 31, hh = lane >> 5;
    const bf16_t* QI = (const bf16_t*)(P.ws + OFF_QI); const bf16_t* KI = (const bf16_t*)(P.ws + OFF_KI); const float* WI = (const float*)(P.ws + OFF_WI);
    float* scr = (float*)(P.ws + OFF_SCR) + (size_t)blockIdx.x * 16 * SEQ;
    const int t0 = 16 * blk; const int qq = r32 >> 4, head = r32 & 15;
    const size_t qrow = (size_t)b * SEQ + t0 + 2 * w;
    bf16x8 af[4];
#pragma unroll
    for (int ks = 0; ks < 4; ++ks) af[ks] = *(const bf16x8*)(QI + (qrow + qq) * 1024 + head * 64 + 16 * ks + 8 * hh);
    f32x4 wv[2][2];
#pragma unroll
    for (int q2 = 0; q2 < 2; ++q2) { wv[q2][0] = *(const f32x4*)(WI + (qrow + q2) * 16 + 4 * hh); wv[q2][1] = *(const f32x4*)(WI + (qrow + q2) * 16 + 8 + 4 * hh); }
    const int nt = (t0 + 16 + 31) >> 5;
    const int nst = (nt + 7) >> 3;
    float* srow = scr + (size_t)(2 * w + hh) * SEQ + r32;
    const bf16_t* kg = KI + (size_t)b * SEQ * 64;
    u32x4 rg[4];
#define IX_GLOAD(st) do { _Pragma("unroll") for (int i = 0; i < 4; ++i) { const int idx = tid + 512 * i; rg[i] = *(const u32x4*)(kg + ((size_t)(st) * IX_SK + (idx >> 3)) * 64 + 8 * (idx & 7)); } } while (0)
#define IX_LWRITE(buf) do { _Pragma("unroll") for (int i = 0; i < 4; ++i) { const int idx = tid + 512 * i; *(LAS u32x4*)(ldsb + (buf) * IX_STAGE + (idx >> 3) * IX_RSTR + 16 * (idx & 7)) = rg[i]; } } while (0)
#ifndef IX_REP
#define IX_REP 1
#endif
    for (int rep_ = 0; rep_ < IX_REP; ++rep_) {
    __syncthreads();
    IX_GLOAD(0); IX_LWRITE(0);
    __syncthreads();
    for (int st = 0; st < nst; ++st) {
        if (st + 1 < nst) IX_GLOAD(st + 1);
        const LAS unsigned char* kb = ldsb + (st & 1) * IX_STAGE + r32 * IX_RSTR + 16 * hh;
#pragma unroll
        for (int jg = 0; jg < 2; ++jg) {
            if (8 * st + 4 * jg < nt) {
                f32x16 acc[4];
#pragma unroll
                for (int j = 0; j < 4; ++j)
#pragma unroll
                    for (int i = 0; i < 16; ++i) acc[j][i] = 0.f;
#pragma unroll
                for (int ks = 0; ks < 4; ++ks)
#pragma unroll
                    for (int j = 0; j < 4; ++j) { const bf16x8 bf = *(const LAS bf16x8*)(kb + (4 * jg + j) * 32 * IX_RSTR + 32 * ks); acc[j] = mfma32(af[ks], bf, acc[j]); }
                float mine[4];
#pragma unroll
                for (int j = 0; j < 4; ++j) { float p0 = 0.f, p1 = 0.f;
#pragma unroll
                    for (int i = 0; i < 4; ++i) { p0 += wv[0][0][i] * relu_asm(acc[j][i]) + wv[0][1][i] * relu_asm(acc[j][4 + i]); p1 += wv[1][0][i] * relu_asm(acc[j][8 + i]) + wv[1][1][i] * relu_asm(acc[j][12 + i]); }
                    const float send = hh ? p0 : p1; mine[j] = (hh ? p1 : p0); acc[j][0] = send; }
#pragma unroll
                for (int j = 0; j < 4; ++j) { const float recv = __shfl_xor(acc[j][0], 32); const int kt = 8 * st + 4 * jg + j; if (kt < nt) srow[32 * kt] = mine[j] + recv; }
            } }
        if (st + 1 < nst) IX_LWRITE((st + 1) & 1);
        __syncthreads();
    }
    }
#undef IX_GLOAD
#undef IX_LWRITE
    asm volatile("s_waitcnt vmcnt(0)" ::: "memory");
    __builtin_amdgcn_fence(__ATOMIC_ACQUIRE, "agent");
    asm volatile("s_waitcnt vmcnt(0)" ::: "memory");
    LAS unsigned* hist = (LAS unsigned*)(ldsb + 2 * IX_STAGE) + w * 2048;
    unsigned long long* MASK = (unsigned long long*)(P.ws + OFF_MASK);
    select_query(scr + (size_t)(2 * w) * SEQ, b, t0 + 2 * w, hist, lane, MASK);
    select_query(scr + (size_t)(2 * w + 1) * SEQ, b, t0 + 2 * w + 1, hist, lane, MASK);
}

constexpr int ATT_STAGE = 32768, ATT_VOFF = 16384, ATT_NS = 4;
__device__ __forceinline__ unsigned cvtpk(float lo, float hi) { f32x2 v = {lo, hi}; bf16x2_t b = __builtin_convertvector(v, bf16x2_t); return __builtin_bit_cast(unsigned, b); }
__device__ __forceinline__ void attn_unit(const Params& P, int b, int h, int qb, bool desc, LAS unsigned char* ldsb) {
    const int tid = threadIdx.x, lane = tid & 63, w = __builtin_amdgcn_readfirstlane(tid >> 6), r32 = lane & 31, hh = lane >> 5;
    const bf16_t* Q = (const bf16_t*)(P.ws + OFF_Q); const bf16_t* Kg = (const bf16_t*)(P.ws + OFF_K); const bf16_t* Vt = (const bf16_t*)(P.ws + OFF_VT);
    const unsigned long long* MASK = (const unsigned long long*)(P.ws + OFF_MASK);
    const int q0 = qb * 256; const size_t qrow = (size_t)b * SEQ + q0 + 32 * w + r32;
    const int NT = 4 * qb + 4;
    const bf16_t* Kbase = Kg + ((size_t)b * SEQ) * D + h * 128;
    const bf16_t* Vbase = Vt + ((size_t)(b * 16 + h) * 128) * SEQ;
    const unsigned* mrow32 = (const unsigned*)(MASK + (size_t)b * 128 * SEQ + q0 + 32 * w) + lane;
    constexpr int ATT_MOFF = ATT_NS * ATT_STAGE;
    unsigned ksrc[2], vsrc[2];
#pragma unroll
    for (int i = 0; i < 2; ++i) { const int ki = 2 * w + i; const int krow = 4 * ki + (lane >> 4), kch = (lane & 15) ^ (krow & 15); ksrc[i] = (unsigned)(krow * D + 8 * kch);
        const int vrow = 8 * ki + (lane >> 3), vch = (lane & 7) ^ ((vrow >> 1) & 7); vsrc[i] = (unsigned)(vrow * SEQ + 8 * vch); }
#define AT_DMA(tt, slot) do { _Pragma("unroll") for (int i = 0; i < 2; ++i) { \
        __builtin_amdgcn_global_load_lds((const unsigned*)(Kbase + (size_t)(tt) * 64 * D + ksrc[i]), (LAS unsigned*)(ldsb + (slot) * ATT_STAGE + (2 * w + i) * 1024), 16, 0, 0); \
        __builtin_amdgcn_global_load_lds((const unsigned*)(Vbase + (size_t)(tt) * 64 + vsrc[i]), (LAS unsigned*)(ldsb + (slot) * ATT_STAGE + ATT_VOFF + (2 * w + i) * 1024), 16, 0, 0); } \
        __builtin_amdgcn_global_load_lds(mrow32 + (size_t)(tt) * SEQ * 2, (LAS unsigned*)(ldsb + ATT_MOFF + (slot) * 2048 + w * 256), 4, 0, 0); } while (0)
    const int kbase0 = r32 * 256 + 16 * (hh ^ (r32 & 15));
    const int vbase0 = ATT_VOFF + r32 * 128 + 16 * (hh ^ ((r32 >> 1) & 7));
    asm volatile("s_waitcnt vmcnt(0) lgkmcnt(0)\n\ts_barrier" ::: "memory");
    bf16x8 qf[8];
#pragma unroll
    for (int ks = 0; ks < 8; ++ks) qf[ks] = *(const bf16x8*)(Q + qrow * D + h * 128 + 16 * ks + 8 * hh);
#define AT_TILE(i) (desc ? (NT - 1 - (i)) : (i))
    AT_DMA(AT_TILE(0), 0);
    AT_DMA(AT_TILE(NT > 1 ? 1 : 0), 1);
    f32x16 o[4];
#pragma unroll
    for (int db = 0; db < 4; ++db)
#pragma unroll
        for (int i = 0; i < 16; ++i) o[db][i] = 0.f;
    float m_ref = -40.f, l_run = 0.f;
    const bool grpB = w >= 4;
#define AT_QK(kb, ks) do { const bf16x8 kf = *(const LAS bf16x8*)(Ks + (kb) * 8192 + (kbase0 ^ (32 * (ks)))); s[kb] = mfma32(kf, qf[ks], s[kb]); } while (0)
#define AT_PV(base, s2, pfrag) do { _Pragma("unroll") for (int db = 0; db < 4; ++db) { const bf16x8 vf = *(const LAS bf16x8*)((base) + db * 4096 + (vbase0 ^ (32 * (s2)))); o[db] = mfma32(vf, pfrag, o[db]); } asm volatile("" ::: "memory"); } while (0)
#define AT_SM1(kb, mxv) do { const unsigned wsh = ((kb) ? (unsigned)(mw >> 32) : (unsigned)mw) >> (4 * hh); mxv = -1e30f; \
            _Pragma("unroll") for (int i = 0; i < 16; ++i) { const bool sel = (wsh & (1u << ((i & 3) + 8 * (i >> 2)))) != 0u; s[kb][i] = sel ? s[kb][i] - m_ref : -1e30f; mxv = fmaxf(mxv, s[kb][i]); } \
            { auto rr = __builtin_amdgcn_permlane32_swap(__float_as_uint(mxv), __float_as_uint(mxv), false, false); mxv = fmaxf(__uint_as_float(rr[0]), __uint_as_float(rr[1])); } } while (0)
#define AT_RESC(kb, mxv) do { if (__any(mxv > 8.0f)) { const float dl = mxv > 8.0f ? mxv : 0.f; m_ref += dl; const float alpha = __builtin_amdgcn_exp2f(-dl); l_run *= alpha; \
            _Pragma("unroll") for (int i = 0; i < 16; ++i) s[kb][i] -= dl; \
            _Pragma("unroll") for (int db = 0; db < 4; ++db) _Pragma("unroll") for (int i = 0; i < 16; ++i) o[db][i] *= alpha; } } while (0)
#define AT_SM2(kb, pa, pb) do { float psum = 0.f; _Pragma("unroll") for (int i = 0; i < 16; ++i) { const float pv = __builtin_amdgcn_exp2f(s[kb][i]); s[kb][i] = pv; psum += pv; } l_run += psum; \
            u32x4 pw; pw.x = cvtpk(s[kb][0], s[kb][1]); pw.y = cvtpk(s[kb][2], s[kb][3]); pw.z = cvtpk(s[kb][4], s[kb][5]); pw.w = cvtpk(s[kb][6], s[kb][7]); pa = __builtin_bit_cast(bf16x8, pw); \
            pw.x = cvtpk(s[kb][8], s[kb][9]); pw.y = cvtpk(s[kb][10], s[kb][11]); pw.z = cvtpk(s[kb][12], s[kb][13]); pw.w = cvtpk(s[kb][14], s[kb][15]); pb = __builtin_bit_cast(bf16x8, pw); } while (0)
#define AT_PSCALE(pf, al) do { u32x4 pq = __builtin_bit_cast(u32x4, pf); _Pragma("unroll") for (int e = 0; e < 4; ++e) { \
            const float lo_ = __builtin_bit_cast(float, pq[e] << 16) * (al), hi_ = __builtin_bit_cast(float, pq[e] & 0xffff0000u) * (al); pq[e] = cvtpk(lo_, hi_); } pf = __builtin_bit_cast(bf16x8, pq); } while (0)
#define AT_HEAD() \
        asm volatile("s_waitcnt vmcnt(5) lgkmcnt(0)\n\ts_barrier" ::: "memory");    \
        const unsigned long long mw = *(const LAS unsigned long long*)(ldsb + ATT_MOFF + (t & 3) * 2048 + w * 256 + r32 * 8); \
        { const int tn = AT_TILE(t + 2 < NT ? t + 2 : NT - 1); AT_DMA(tn, ((t + 2) & 3)); }     \
        const LAS unsigned char* Ks = ldsb + (t & 3) * ATT_STAGE; \
        f32x16 s[2]; float mx0, mx1; \
        _Pragma("unroll") for (int i = 0; i < 16; ++i) { s[0][i] = 0.f; s[1][i] = 0.f; }
    if (!grpB) {
        for (int t = 0; t < NT; ++t) {
            AT_HEAD();
#pragma unroll
            for (int ks = 0; ks < 8; ++ks) AT_QK(0, ks);
            asm volatile("" ::: "memory");
#pragma unroll
            for (int ks = 0; ks < 8; ++ks) AT_QK(1, ks);
            asm volatile("" ::: "memory");
            bf16x8 p0a, p0b, p1a, p1b;
            AT_SM1(0, mx0);
            AT_RESC(0, mx0);
            AT_SM2(0, p0a, p0b);
            AT_PV(Ks, 0, p0a); AT_PV(Ks, 1, p0b);
            AT_SM1(1, mx1);
            AT_RESC(1, mx1);
            AT_SM2(1, p1a, p1b);
            AT_PV(Ks, 2, p1a); AT_PV(Ks, 3, p1b);
        }
    } else {
        bf16x8 p0a = {0, 0, 0, 0, 0, 0, 0, 0}, p0b = p0a, p1a = p0a, p1b = p0a;
        for (int t = 0; t < NT; ++t) {
            AT_HEAD();
            if (t > 0) { const LAS unsigned char* Kp = ldsb + ((t + 3) & 3) * ATT_STAGE; AT_PV(Kp, 0, p0a); AT_PV(Kp, 1, p0b); AT_PV(Kp, 2, p1a); AT_PV(Kp, 3, p1b); }
#pragma unroll
            for (int ks = 0; ks < 8; ++ks) AT_QK(0, ks);
            asm volatile("" ::: "memory");
#pragma unroll
            for (int ks = 0; ks < 8; ++ks) AT_QK(1, ks);
            asm volatile("" ::: "memory");
            AT_SM1(0, mx0);
            AT_RESC(0, mx0);
            AT_SM2(0, p0a, p0b);
            AT_SM1(1, mx1);
            if (__any(mx1 > 8.0f)) { const float al = __builtin_amdgcn_exp2f(-(mx1 > 8.0f ? mx1 : 0.f)); AT_PSCALE(p0a, al); AT_PSCALE(p0b, al); }
            AT_RESC(1, mx1);
            AT_SM2(1, p1a, p1b);
        }
        { const LAS unsigned char* Kp = ldsb + ((NT - 1) & 3) * ATT_STAGE; AT_PV(Kp, 0, p0a); AT_PV(Kp, 1, p0b); AT_PV(Kp, 2, p1a); AT_PV(Kp, 3, p1b); }
    }
#undef AT_HEAD
#undef AT_TILE
#undef AT_QK
#undef AT_PV
#undef AT_SM1
#undef AT_RESC
#undef AT_SM2
#undef AT_PSCALE
#undef AT_DMA
    asm volatile("s_waitcnt vmcnt(0)" ::: "memory");
    float l_tot; { auto rr = __builtin_amdgcn_permlane32_swap(__float_as_uint(l_run), __float_as_uint(l_run), false, false); l_tot = __uint_as_float(rr[0]) + __uint_as_float(rr[1]); }
    const float rl = 1.0f / l_tot;
    bf16_t* orow = (bf16_t*)(P.ws + OFF_O) + qrow * D + h * 128;
#pragma unroll
    for (int db = 0; db < 4; ++db)
#pragma unroll
        for (int i4 = 0; i4 < 4; ++i4) { u32x2 wv; wv.x = cvtpk(o[db][4 * i4] * rl, o[db][4 * i4 + 1] * rl); wv.y = cvtpk(o[db][4 * i4 + 2] * rl, o[db][4 * i4 + 3] * rl);
            *(u32x2*)(orow + 32 * db + 8 * i4 + 4 * hh) = wv; }
}


#define XB_TMO      128
#define XB_XCNT(j)  (256  + 64 * (j))
#define XB_XSUB(j)  (1280 + 64 * (j))
#define XB_XGEN(j)  (2304 + 64 * (j))
#define XB_TOP      3328
#define XB_TOPGEN   3392
#define XCD_BAR_WORDS 3456
#define XB_SPIN_CAP (1u << 18)
__device__ __forceinline__ unsigned xb_ld(unsigned* p)              { return __hip_atomic_load(p, __ATOMIC_RELAXED, __HIP_MEMORY_SCOPE_AGENT); }
__device__ __forceinline__ unsigned xb_add(unsigned* p, unsigned v) { return __hip_atomic_fetch_add(p, v, __ATOMIC_RELAXED, __HIP_MEMORY_SCOPE_AGENT); }
__device__ __forceinline__ unsigned xb_xcc_id() { return (unsigned)__builtin_amdgcn_s_getreg((3 << 11) | 20) & 0xFu; }
#define XB_SPIN(cond, bar) do { unsigned _sp = 0; while (cond) { __builtin_amdgcn_s_sleep(1); \
    if ((++_sp & 255u) == 0u) { if (xb_ld(&(bar)[XB_TMO])) break; if (_sp > XB_SPIN_CAP) { atomicAdd(&(bar)[XB_TMO], 1u); break; } } } } while (0)
struct XcdBarrier { unsigned* bar; unsigned x; volatile LAS unsigned* st; };
__device__ __forceinline__ XcdBarrier xcd_barrier_post(unsigned* bar, volatile LAS unsigned* st) {
    XcdBarrier b; b.bar = bar; b.x = xb_xcc_id(); b.st = st;
    if (threadIdx.x == 0) (void)xb_add(&bar[XB_XCNT(b.x)], 1u);
    return b;
}
__device__ __forceinline__ void xcd_barrier_complete(unsigned* bar, unsigned x, unsigned& nloc, unsigned& nx) {
    const unsigned G = gridDim.x * gridDim.y * gridDim.z;
    unsigned sum, cnt, mine, sp = 0u;
    for (;;) {
        sum = 0u; cnt = 0u; mine = 0u;
#pragma unroll
        for (unsigned j = 0; j < 16; ++j) { const unsigned c = xb_ld(&bar[XB_XCNT(j)]); sum += c; cnt += (c > 0u) ? 1u : 0u; mine = (j == x) ? c : mine; }
        if (sum == G) break;
        __builtin_amdgcn_s_sleep(1);
        if ((++sp & 255u) == 0u) { if (xb_ld(&bar[XB_TMO])) break; if (sp > XB_SPIN_CAP) { atomicAdd(&bar[XB_TMO], 1u); break; } }
    }
    nloc = mine > 0u ? mine : 1u; nx = cnt > 0u ? cnt : 1u;
}
__device__ __forceinline__ void xcd_barrier(const XcdBarrier& b) {
    asm volatile("s_waitcnt vmcnt(0)" ::: "memory");
    __syncthreads();
    if (threadIdx.x == 0) {
        unsigned* bar = b.bar;
        __builtin_amdgcn_s_waitcnt(0);
        unsigned nloc = b.st[0], nx = b.st[1];
        if (nloc == 0u) { xcd_barrier_complete(bar, b.x, nloc, nx); b.st[0] = nloc; b.st[1] = nx; }
        const unsigned old = xb_add(&bar[XB_XSUB(b.x)], 1u);
        const unsigned gen = old / nloc;
        if (old + 1u == (gen + 1u) * nloc) {
            __builtin_amdgcn_fence(__ATOMIC_RELEASE, "agent");
            asm volatile("s_waitcnt vmcnt(0)" ::: "memory");
            (void)xb_add(&bar[XB_TOP], 1u);
        }
        const unsigned want = (gen + 1u) * nx;
        XB_SPIN(xb_ld(&bar[XB_TOP]) < want, bar);
        __builtin_amdgcn_fence(__ATOMIC_ACQUIRE, "agent");
        asm volatile("s_waitcnt vmcnt(0)" ::: "memory");
    }
    __syncthreads();
}
constexpr size_t OFF_STATS = 512 * 1024;
constexpr size_t OFF_BAR = 200 * 1024;
constexpr int LDS_BARST = LDS_BYTES - 64;

__global__ void __launch_bounds__(NTHR, 2) fwd_kernel(Params P) {
    extern __shared__ __attribute__((aligned(16))) unsigned char lds_raw[];
    LAS unsigned char* lds = (LAS unsigned char*)lds_raw;
    cg::grid_group grid = cg::this_grid();
    const int tid = threadIdx.x, lane = tid & 63, wave = tid >> 6; const int G = gridDim.x;
    unsigned char* ws = P.ws;
    const float* MOD = (const float*)(ws + OFF_MOD);
#define MODP(layer, idx) (MOD + ((size_t)(layer) * 2 * 6 + (idx)) * D)
    const int lo = P.ph_lo, hi = P.ph_hi;
    volatile LAS unsigned* xst = (volatile LAS unsigned*)(lds + LDS_BARST);
    if (tid < 2) xst[tid] = 0u;
    __syncthreads();
    XcdBarrier xbar; xbar.bar = (unsigned*)(ws + OFF_BAR); xbar.x = 0; xbar.st = xst;
    if (hi - lo > 1) xbar = xcd_barrier_post((unsigned*)(ws + OFF_BAR), xst);
    if (hi > 1000) grid.sync();
#ifndef PHMASK
#define PHMASK 0x1ffff
#endif
#define IN(k) (((PHMASK >> (k)) & 1) && lo <= (k) && (k) < hi)
#ifndef REPMASK
#define REPMASK 0
#endif
#define REPN(k) ((((REPMASK) >> (k)) & 1) ? 2 : 1)
#define SEAM(k) do { if (IN(k) && IN((k) + 1)) xcd_barrier(xbar); } while (0)

    if (IN(0)) for (int rep_ = 0; rep_ < REPN(0); ++rep_) {
        if (G == 256) { if (blockIdx.x < 128) s5_table_item(P, blockIdx.x, (LAS float*)lds);
                        else { mod_item(P, blockIdx.x - 128, (LAS float*)lds); if (blockIdx.x < 192) mod_item(P, blockIdx.x, (LAS float*)lds); } }
        else for (int it = blockIdx.x; it < 192 + 128; it += G) { if (it < 192) mod_item(P, it, (LAS float*)lds); else s5_table_item(P, it - 192, (LAS float*)lds); }
        __syncthreads();
        LAS float* scr = (LAS float*)(lds + wave * 16384);
        const int gw = blockIdx.x * NW + wave, NGW = G * NW;
        constexpr int I0 = 32 * 64, I1 = 32 * 128, I2 = 32 * 352, I4 = 88 * 64, I6 = 32 * 227, I7 = 32 * 64, IR = 256;
        constexpr int NIT = I0 + I1 + 2 * I2 + 2 * I4 + I6 + I7 + IR;
        for (int it = gw; it < NIT; it += NGW) {
            int r = it; const float* W; bf16_t* WT; int K_, N_, mode;
            if (r < I0) { W = P.s5_in_w; WT = (bf16_t*)(ws + OFF_W_S5IN); K_ = D; N_ = D; mode = 0; }
            else if ((r -= I0) < I1) { W = P.glu_w; WT = (bf16_t*)(ws + OFF_W_GLU); K_ = D; N_ = 2 * D; mode = 1; }
            else if ((r -= I1) < I2) { W = P.ffn_w_in; WT = (bf16_t*)(ws + OFF_W_FIN0); K_ = D; N_ = 2 * DFF; mode = 2; }
            else if ((r -= I2) < I2) { W = P.ffn_w_in + (size_t)D * 2 * DFF; WT = (bf16_t*)(ws + OFF_W_FIN1); K_ = D; N_ = 2 * DFF; mode = 2; }
            else if ((r -= I2) < I4) { W = P.ffn_w_out; WT = (bf16_t*)(ws + OFF_W_FOUT0); K_ = DFF; N_ = D; mode = 0; }
            else if ((r -= I4) < I4) { W = P.ffn_w_out + (size_t)DFF * D; WT = (bf16_t*)(ws + OFF_W_FOUT1); K_ = DFF; N_ = D; mode = 0; }
            else if ((r -= I4) < I6) { W = P.dsa_in_w; WT = (bf16_t*)(ws + OFF_W_DIN); K_ = D; N_ = DSA_IN; mode = 3; }
            else if ((r -= I6) < I7) { W = P.dsa_out_w; WT = (bf16_t*)(ws + OFF_W_DOUT); K_ = D; N_ = D; mode = 0; }
            else { r -= I7; rope_item(P, r, lane); continue; }
            transpose_item(W, K_, N_, WT, mode, scr, r, lane);
        }
        __syncthreads();
    }
    SEAM(0);
#ifdef EXTRA_SYNCS
    for (int e_ = 0; e_ < EXTRA_SYNCS; ++e_) grid.sync();
#endif
    if (IN(1)) for (int rep_ = 0; rep_ < REPN(1); ++rep_) row_pass<0>(P.x, nullptr, nullptr, MODP(0, 1), MODP(0, 0), nullptr, (bf16_t*)(ws + OFF_HB), G);
    SEAM(1);
    if (IN(2)) for (int rep_ = 0; rep_ < REPN(2); ++rep_) { pg8::Gemm g{(const bf16_t*)(ws + OFF_HB), (const bf16_t*)(ws + OFF_W_S5IN), M, D, D}; pg8::StaticOrder S; S.init(M, D, G, blockIdx.x);
        EpiU E{(bf16_t*)(ws + OFF_UG)}; pg8::gemm_phase(lds, g, S, E); }
    SEAM(2);
    if (IN(3)) for (int rep_ = 0; rep_ < REPN(3); ++rep_) { for (int it = blockIdx.x; it < 256; it += G) {
            int g = it >> 1, b = it & 1;
            if (G == 256) { const int x = it & 7, k = it >> 3, j = x + 8 * (k >> 3), sub = k & 7; g = 4 * j + (sub >> 1); b = sub & 1; }
            s5_item(P, g, b, lds); } }
    SEAM(3);
    if (IN(4)) for (int rep_ = 0; rep_ < REPN(4); ++rep_) { pg8::Gemm g{(const bf16_t*)(ws + OFF_G), (const bf16_t*)(ws + OFF_W_GLU), M, 2 * D, D}; pg8::StaticOrder S; S.init(M, 2 * D, G, blockIdx.x);
        EpiGLU E{P.glu_b, P.x, MODP(0, 2), (bf16_t*)(ws + OFF_V)}; pg8::gemm_phase(lds, g, S, E); }
    SEAM(4);
    if (IN(5)) for (int rep_ = 0; rep_ < REPN(5); ++rep_) row_pass<1>((const void*)(ws + OFF_V), P.ln_g, P.ln_b, MODP(0, 4), MODP(0, 3), (float*)(ws + OFF_STATS), (bf16_t*)(ws + OFF_HB), G);
    SEAM(5);
    if (IN(6)) for (int rep_ = 0; rep_ < REPN(6); ++rep_) { pg8::Gemm g{(const bf16_t*)(ws + OFF_HB), (const bf16_t*)(ws + OFF_W_FIN0), M, 2 * DFF, D}; pg8::StaticOrder S; S.init(M, 2 * DFF, G, blockIdx.x);
        EpiSwiGLU E{(bf16_t*)(ws + OFF_ACT)}; pg8::gemm_phase(lds, g, S, E); }
    SEAM(6);
    if (IN(7)) for (int rep_ = 0; rep_ < REPN(7); ++rep_) { pg8::Gemm g{(const bf16_t*)(ws + OFF_ACT), (const bf16_t*)(ws + OFF_W_FOUT0), M, D, DFF}; pg8::StaticOrder S; S.init(M, D, G, blockIdx.x);
        EpiRes E{(const bf16_t*)(ws + OFF_V), (const f32x2*)(ws + OFF_STATS), P.ln_g, P.ln_b, MODP(0, 5), (bf16_t*)(ws + OFF_X)}; pg8::gemm_phase(lds, g, S, E); }
    SEAM(7);
    if (IN(8)) for (int rep_ = 0; rep_ < REPN(8); ++rep_) row_pass<1>((const void*)(ws + OFF_X), P.ln_g + D, P.ln_b + D, MODP(1, 1), MODP(1, 0), (float*)(ws + OFF_STATS), (bf16_t*)(ws + OFF_HB), G);
    SEAM(8);
    if (IN(9)) for (int rep_ = 0; rep_ < REPN(9); ++rep_) { pg8::Gemm g{(const bf16_t*)(ws + OFF_HB), (const bf16_t*)(ws + OFF_W_DIN), M, DSA_NP, D}; pg8::StaticOrder S; S.init(M, DSA_NP, G, blockIdx.x);
        EpiDSA E{(bf16_t*)(ws + OFF_Q), (bf16_t*)(ws + OFF_K), (bf16_t*)(ws + OFF_VT), (bf16_t*)(ws + OFF_QI), (bf16_t*)(ws + OFF_KI), (float*)(ws + OFF_WI),
                 (const f32x2*)(ws + OFF_CSH), (const f32x2*)(ws + OFF_CSI)}; pg8::gemm_phase(lds, g, S, E); }
    SEAM(9);
    if (IN(10)) for (int rep_ = 0; rep_ < REPN(10); ++rep_) { for (int j = blockIdx.x; j < 1024; j += G) { const int b = j >> 9, jj = j & 511; const int blk = jj < 256 ? jj : 767 - jj; indexer_block(P, b, blk, lds); } }
    SEAM(10);
    if (IN(11)) for (int rep_ = 0; rep_ < REPN(11); ++rep_) {
        const int nu = (G == 256) ? 4 : (1024 - (int)blockIdx.x + G - 1) / G;
        for (int u = 0; u < nu; ++u) {
            int bh, qb; bool dsc;
            if (G == 256) { const int x = blockIdx.x & 7, li = blockIdx.x >> 3, gsel = li >> 4, p = li & 15; bh = x * 4 + 2 * (u >> 1) + gsel; dsc = (u & 1) != 0; qb = dsc ? 31 - p : p; }
            else { const int i = blockIdx.x + u * G; bh = i & 31; qb = 31 - (i >> 5); dsc = false; }
            attn_unit(P, bh >> 4, bh & 15, qb, dsc, lds);
        }
    }
    SEAM(11);
    if (IN(12)) for (int rep_ = 0; rep_ < REPN(12); ++rep_) { pg8::Gemm g{(const bf16_t*)(ws + OFF_O), (const bf16_t*)(ws + OFF_W_DOUT), M, D, D}; pg8::StaticOrder S; S.init(M, D, G, blockIdx.x);
        EpiRes E{(const bf16_t*)(ws + OFF_X), (const f32x2*)(ws + OFF_STATS), P.ln_g + D, P.ln_b + D, MODP(1, 2), (bf16_t*)(ws + OFF_V)}; pg8::gemm_phase(lds, g, S, E); }
    SEAM(12);
    if (IN(13)) for (int rep_ = 0; rep_ < REPN(13); ++rep_) row_pass<1>((const void*)(ws + OFF_V), P.ln_g + 2 * D, P.ln_b + 2 * D, MODP(1, 4), MODP(1, 3), (float*)(ws + OFF_STATS), (bf16_t*)(ws + OFF_HB), G);
    SEAM(13);
    if (IN(14)) for (int rep_ = 0; rep_ < REPN(14); ++rep_) { pg8::Gemm g{(const bf16_t*)(ws + OFF_HB), (const bf16_t*)(ws + OFF_W_FIN1), M, 2 * DFF, D}; pg8::StaticOrder S; S.init(M, 2 * DFF, G, blockIdx.x);
        EpiSwiGLU E{(bf16_t*)(ws + OFF_ACT)}; pg8::gemm_phase(lds, g, S, E); }
    SEAM(14);
    if (IN(15)) for (int rep_ = 0; rep_ < REPN(15); ++rep_) { pg8::Gemm g{(const bf16_t*)(ws + OFF_ACT), (const bf16_t*)(ws + OFF_W_FOUT1), M, D, DFF}; pg8::StaticOrder S; S.init(M, D, G, blockIdx.x);
        EpiRes E{(const bf16_t*)(ws + OFF_V), (const f32x2*)(ws + OFF_STATS), P.ln_g + 2 * D, P.ln_b + 2 * D, MODP(1, 5), (bf16_t*)(ws + OFF_X)}; pg8::gemm_phase(lds, g, S, E); }
    SEAM(15);
    if (IN(16)) for (int rep_ = 0; rep_ < REPN(16); ++rep_) row_pass<2>((const void*)(ws + OFF_X), P.ln_g + 3 * D, P.ln_b + 3 * D, nullptr, nullptr, P.out, nullptr, G);
#undef IN
#undef SEAM
#undef MODP
}

#ifndef MK_SPLIT
#define MK_SPLIT 0
#endif
constexpr int NPHASE = 17;

extern "C" void kernel_launch(void* const* d_in, const int* in_sizes, int n_in, void* d_out, int out_size, void* d_ws, size_t ws_size, hipStream_t stream) {
    static int grid = 0;
    if (grid == 0) {
        if (n_in != 22 || out_size != M * D || ws_size < WS_NEED) { fprintf(stderr, "kernel_launch: unexpected shapes (n_in %d out %d ws %zu)\n", n_in, out_size, ws_size); grid = -1; return; }
        int dev = 0, cus = 0, per_cu = 0;
        hipGetDevice(&dev); hipDeviceGetAttribute(&cus, hipDeviceAttributeMultiprocessorCount, dev);
        hipFuncSetAttribute((const void*)fwd_kernel, hipFuncAttributeMaxDynamicSharedMemorySize, LDS_BYTES);
        hipOccupancyMaxActiveBlocksPerMultiprocessor(&per_cu, (const void*)fwd_kernel, NTHR, LDS_BYTES);
        if (per_cu < 1) per_cu = 1;
        grid = cus * per_cu; if (grid > 256) grid = 256;
        (void)hipGetLastError();
    }
    if (grid < 0) return;
    Params p{};
    p.x = (const float*)d_in[0]; p.c = (const float*)d_in[1]; p.pos = (const int*)d_in[2]; p.ada_w = (const float*)d_in[3]; p.ada_b = (const float*)d_in[4];
    p.ln_g = (const float*)d_in[5]; p.ln_b = (const float*)d_in[6]; p.s5_in_w = (const float*)d_in[7]; p.a_re = (const float*)d_in[8]; p.a_im = (const float*)d_in[9];
    p.log_dt = (const float*)d_in[10]; p.b_re = (const float*)d_in[11]; p.b_im = (const float*)d_in[12]; p.c_re = (const float*)d_in[13]; p.c_im = (const float*)d_in[14];
    p.s5_d = (const float*)d_in[15]; p.glu_w = (const float*)d_in[16]; p.glu_b = (const float*)d_in[17]; p.dsa_in_w = (const float*)d_in[18]; p.dsa_out_w = (const float*)d_in[19];
    p.ffn_w_in = (const float*)d_in[20]; p.ffn_w_out = (const float*)d_in[21];
    p.out = (float*)d_out; p.ws = (unsigned char*)d_ws;
#if MK_SPLIT
    for (int ph = 0; ph < NPHASE; ++ph) { p.ph_lo = ph; p.ph_hi = ph + 1; hipLaunchKernelGGL(fwd_kernel, dim3(grid), dim3(NTHR), LDS_BYTES, stream, p); }
#else
    p.ph_lo = 0; p.ph_hi = NPHASE;
    (void)hipMemsetAsync((char*)d_ws + OFF_BAR, 0, 16384, stream);
    void* args[] = {&p};
    hipError_t e = hipLaunchCooperativeKernel((const void*)fwd_kernel, dim3(grid), dim3(NTHR), args, LDS_BYTES, stream);
    if (e != hipSuccess) fprintf(stderr, "cooperative launch failed: %s (grid %d)\n", hipGetErrorString(e), grid);
#endif
}
```

```cpp
#include <hip/hip_runtime.h>
#include <hip/hip_cooperative_groups.h>
#include <cstdio>
#include <cstdint>
namespace cg = cooperative_groups;

#define LAS __attribute__((address_space(3)))
typedef unsigned short bf16_t;
typedef short bf16x8 __attribute__((ext_vector_type(8)));
typedef float f32x4 __attribute__((ext_vector_type(4)));
typedef float f32x2 __attribute__((ext_vector_type(2)));
typedef float f32x16 __attribute__((ext_vector_type(16)));
typedef unsigned u32x4 __attribute__((ext_vector_type(4)));
typedef unsigned u32x2 __attribute__((ext_vector_type(2)));

constexpr int D = 2048, SEQ = 8192, M = 16384, DFF = 5632, DSA_IN = 7248, DSA_NP = 7424;
constexpr float ALPHA = 1.41421356237309515f, LN_EPS = 1e-5f;
constexpr float QSCALE = 0.08838834764831845f * 1.4426950408889634f;
constexpr int NTHR = 512, NW = 8;
constexpr int LDS_BYTES = 147456;
constexpr int CH_T = 32, NCH = SEQ / CH_T;
constexpr int ESTR = 132;

constexpr size_t MiB = 1u << 20;
constexpr size_t OFF_MOD = 0, OFF_LAMT = 256 * 1024, OFF_CSH = 1 * MiB, OFF_CSI = 9 * MiB, OFF_KM = 13 * MiB, OFF_WE = 15 * MiB, OFF_WP = 31 * MiB;
constexpr size_t OFF_W_S5IN = 47 * MiB, OFF_W_GLU = 55 * MiB, OFF_W_FIN0 = 71 * MiB, OFF_W_FIN1 = 115 * MiB, OFF_W_FOUT0 = 159 * MiB, OFF_W_FOUT1 = 181 * MiB;
constexpr size_t OFF_W_DIN = 203 * MiB, OFF_W_DOUT = 232 * MiB;
constexpr size_t OFF_X = 240 * MiB, OFF_V = 368 * MiB, OFF_HB = 496 * MiB, OFF_ACT = 560 * MiB;
constexpr size_t OFF_UG = 560 * MiB, OFF_G = 624 * MiB;
constexpr size_t OFF_Q = 560 * MiB, OFF_K = 624 * MiB, OFF_VT = 688 * MiB, OFF_KI = 752 * MiB, OFF_WI = 754 * MiB;
constexpr size_t OFF_QI = 368 * MiB, OFF_MASK = 400 * MiB, OFF_SCR = 416 * MiB;
constexpr size_t OFF_O = OFF_HB;
constexpr size_t WS_NEED = 756 * MiB;

struct Params {
    const float *x, *c; const int* pos; const float *ada_w, *ada_b, *ln_g, *ln_b, *s5_in_w, *a_re, *a_im, *log_dt, *b_re, *b_im, *c_re, *c_im, *s5_d,
        *glu_w, *glu_b, *dsa_in_w, *dsa_out_w, *ffn_w_in, *ffn_w_out;
    float* out; unsigned char* ws; int ph_lo, ph_hi;
};

__device__ __forceinline__ unsigned f2bf(float f) { unsigned u = __builtin_bit_cast(unsigned, f); return (u + 0x7fffu + ((u >> 16) & 1u)) >> 16; }
typedef __bf16 bf16x2_t __attribute__((ext_vector_type(2)));
__device__ __forceinline__ unsigned pk2(float lo, float hi) { f32x2 v = {lo, hi}; bf16x2_t b = __builtin_convertvector(v, bf16x2_t); return __builtin_bit_cast(unsigned, b); }
__device__ __forceinline__ float bf2f(unsigned short v) { return __builtin_bit_cast(float, ((unsigned)v) << 16); }
__device__ __forceinline__ float sigmoidf_(float v) { return __builtin_amdgcn_rcpf(1.0f + __expf(-v)); }
__device__ __forceinline__ f32x16 mfma32(bf16x8 a, bf16x8 b, f32x16 c) { return __builtin_amdgcn_mfma_f32_32x32x16_bf16(a, b, c, 0, 0, 0); }
__device__ __forceinline__ int crow(int r, int hi) { return (r & 3) + 8 * (r >> 2) + 4 * hi; }
__device__ __forceinline__ float wave_sum(float v) {
#pragma unroll
    for (int o = 1; o < 64; o <<= 1) v += __shfl_xor(v, o);
    return v;
}
__device__ __forceinline__ void sincos_rev(double rev, float& s, float& c) {
    double fr = rev - floor(rev); float f = (float)fr; s = __builtin_amdgcn_sinf(f); c = __builtin_amdgcn_cosf(f);
}

namespace pg8 {
constexpr int BM = 256, BK = 64, HALF = 128, HTB = HALF * BK * 2, STAGE_BYTES = 8 * HTB, NXCD = 8, WGM = 8;
__host__ __device__ __forceinline__ int lds_byte(int r, int c) { const int st = (r >> 4) * 2 + (c >> 5), rr = r & 15, cc = c & 31, ob = rr * 64 + cc * 2; return st * 1024 + (ob ^ (((ob >> 9) & 1) << 5)); }
__host__ __device__ __forceinline__ void stage_rc(int b, int& R, int& C) { const int st = b / 1024, sb = b % 1024, swz = sb ^ (((sb >> 9) & 1) << 5); R = (st >> 1) * 16 + swz / 64; C = (st & 1) * 32 + (swz % 64) / 2; }
__host__ __device__ __forceinline__ int perm32(int rho) { const int n = rho >> 4, i = rho & 15; return 8 * (i >> 2) + 4 * n + (i & 3); }
struct Unit { int pm, pn; };
struct Gemm { const bf16_t* A; const bf16_t* Bt; int M, N, K; };
struct StaticOrder {
    int nM, nN, nwg, G, c;
    __device__ void init(int M_, int N_, int G_, int c_) { nM = M_ / BM; nN = N_ / BM; nwg = nM * nN; G = G_; c = c_; }
    __device__ bool next(int i, Unit& u) const {
        const long L = (long)i * G + c; if (L >= nwg) return false;
        int wgid = (int)L; { const int q = nwg / NXCD, r = nwg % NXCD, xcd = wgid % NXCD, off = wgid / NXCD; wgid = (xcd < r ? xcd * (q + 1) : r * (q + 1) + (xcd - r) * q) + off; }
        const int nig = WGM * nN, gid = wgid / nig, fm = gid * WGM, gsz = (nM - fm) < WGM ? (nM - fm) : WGM;
        u.pm = fm + ((wgid % nig) % gsz); u.pn = (wgid % nig) / gsz; return true;
    }
};
__device__ __forceinline__ unsigned cvt_pk_bf16(float lo, float hi) { unsigned r; asm volatile("v_cvt_pk_bf16_f32 %0, %1, %2" : "=v"(r) : "v"(lo), "v"(hi)); return r; }

template <class Epi>
__device__ __forceinline__ void gemm_phase(LAS unsigned char* lds, const Gemm g, const StaticOrder& S, const Epi& E) {
    const int tid = threadIdx.x, wid = __builtin_amdgcn_readfirstlane(tid >> 6), lane = tid & 63, wr = wid >> 2, wc = wid & 3, fr = lane & 15, fq = lane >> 4;
    const int K = g.K, nt = K / BK;
    unsigned voffA[2], voffB[2];
#pragma unroll
    for (int i = 0; i < 2; ++i) { int R, C; stage_rc(tid * 16 + i * 8192, R, C); const int Rb = (R & ~31) + perm32(R & 31);
        voffA[i] = (unsigned)(R * K + C) * 2u; voffB[i] = (unsigned)(Rb * K + C) * 2u; }
    const size_t kstep = (size_t)(BK * 2);
    const size_t hstep = (size_t)HALF * K * 2;
    const size_t tstep = 2 * hstep;
    const unsigned ldsw = (unsigned)wid * 1024u;
    const int aoff = lds_byte(wr * 64 + fr, fq * 8), boff = lds_byte(wc * 32 + fr, fq * 8);
#define PG8_SA(b, h) (((b) * 2 + (h)) * HTB)
#define PG8_SB(b, h) ((4 + (b) * 2 + (h)) * HTB)
#define PG8_STAGE(bufoff, gbase, voff) do { _Pragma("unroll") for (int _i = 0; _i < 2; ++_i) \
        __builtin_amdgcn_global_load_lds((const unsigned*)((const char*)(gbase) + (voff)[_i]), (LAS unsigned*)(lds + (bufoff) + ldsw + _i * 8192), 16, 0, 0); } while (0)
#define PG8_LDA(dst, b, h) do { _Pragma("unroll") for (int m = 0; m < 4; ++m) _Pragma("unroll") for (int k = 0; k < 2; ++k) dst[m][k] = *(const LAS bf16x8*)(lds + PG8_SA(b, h) + aoff + m * 2048 + k * 1024); } while (0)
#define PG8_LDB(dst, b, h) do { _Pragma("unroll") for (int n = 0; n < 2; ++n) _Pragma("unroll") for (int k = 0; k < 2; ++k) dst[n][k] = *(const LAS bf16x8*)(lds + PG8_SB(b, h) + boff + n * 2048 + k * 1024); } while (0)
#define PG8_MMA(ai, bj, At, Bt) do { __builtin_amdgcn_s_setprio(1); _Pragma("unroll") for (int m = 0; m < 4; ++m) _Pragma("unroll") for (int n = 0; n < 2; ++n) _Pragma("unroll") for (int k = 0; k < 2; ++k) \
        acc[ai][bj][m][n] = __builtin_amdgcn_mfma_f32_16x16x32_bf16(Bt[n][k], At[m][k], acc[ai][bj][m][n], 0, 0, 0); __builtin_amdgcn_s_setprio(0); } while (0)
#define PG8_WAIT_V(n) asm volatile("s_waitcnt vmcnt(" #n ")" ::: "memory")
#define PG8_WAIT_L(n) asm volatile("s_waitcnt lgkmcnt(" #n ")" ::: "memory")
#define PG8_BAR __builtin_amdgcn_s_barrier()
#define PG8_SCHED __builtin_amdgcn_sched_barrier(0)
    Unit cur, nxt; int ui = 0;
    if (!S.next(0, cur)) return;
    f32x4 acc[2][2][4][2];
#pragma unroll
    for (int a = 0; a < 2; ++a)
#pragma unroll
        for (int b = 0; b < 2; ++b)
#pragma unroll
            for (int m = 0; m < 4; ++m)
#pragma unroll
                for (int n = 0; n < 2; ++n) acc[a][b][m][n] = (f32x4){0.f, 0.f, 0.f, 0.f};
    bf16x8 At[4][2], B0[2][2], B1[2][2];
    const char* cA = (const char*)g.A + (size_t)cur.pm * tstep; const char* cB = (const char*)g.Bt + (size_t)cur.pn * tstep;
    PG8_STAGE(PG8_SB(0, 0), cB, voffB); PG8_STAGE(PG8_SB(0, 1), cB + hstep, voffB); PG8_STAGE(PG8_SA(0, 0), cA, voffA); PG8_STAGE(PG8_SA(0, 1), cA + hstep, voffA);
    if (wr == 1) PG8_BAR;
    PG8_WAIT_V(2); PG8_BAR;
    PG8_STAGE(PG8_SB(1, 0), cB + kstep, voffB); PG8_STAGE(PG8_SA(1, 0), cA + kstep, voffA); PG8_STAGE(PG8_SB(1, 1), cB + hstep + kstep, voffB);
    PG8_WAIT_V(6); PG8_BAR;
    for (;;) {
        const bool has_next = S.next(ui + 1, nxt);
        const char* nA = has_next ? (const char*)g.A + (size_t)nxt.pm * tstep : cA; const char* nB = has_next ? (const char*)g.Bt + (size_t)nxt.pn * tstep : cB;
        for (int t = 0; t < nt; t += 2) {
            const bool last = (t == nt - 2);
            const char* a1 = cA + (size_t)(t + 1) * kstep;
            const char* a2 = last ? nA : cA + (size_t)(t + 2) * kstep; const char* b2 = last ? nB : cB + (size_t)(t + 2) * kstep;
            const char* a3 = a2 + kstep; const char* b3 = b2 + kstep;
            PG8_LDB(B0, 0, 0); PG8_LDB(B1, 0, 1); PG8_SCHED; PG8_LDA(At, 0, 0); PG8_STAGE(PG8_SA(1, 1), a1 + hstep, voffA);
            PG8_WAIT_V(8); PG8_WAIT_L(0); PG8_BAR; PG8_MMA(0, 0, At, B0); PG8_MMA(0, 1, At, B1); PG8_BAR; PG8_SCHED;
            PG8_LDA(At, 0, 1); PG8_STAGE(PG8_SB(0, 0), b2, voffB); PG8_STAGE(PG8_SB(0, 1), b2 + hstep, voffB); PG8_STAGE(PG8_SA(0, 0), a2, voffA);
            PG8_WAIT_V(8); PG8_WAIT_L(0); PG8_BAR; PG8_MMA(1, 0, At, B0); PG8_MMA(1, 1, At, B1); PG8_BAR; PG8_SCHED;
            PG8_LDB(B0, 1, 0); PG8_LDB(B1, 1, 1); PG8_SCHED; PG8_LDA(At, 1, 0); PG8_STAGE(PG8_SA(0, 1), a2 + hstep, voffA);
            PG8_WAIT_V(8); PG8_WAIT_L(0); PG8_BAR; PG8_MMA(0, 0, At, B0); PG8_MMA(0, 1, At, B1); PG8_BAR; PG8_SCHED;
            PG8_LDA(At, 1, 1); PG8_STAGE(PG8_SB(1, 0), b3, voffB); PG8_STAGE(PG8_SB(1, 1), b3 + hstep, voffB); PG8_STAGE(PG8_SA(1, 0), a3, voffA);
            PG8_WAIT_V(8); PG8_WAIT_L(0); PG8_BAR; PG8_MMA(1, 0, At, B0); PG8_MMA(1, 1, At, B1); PG8_BAR; PG8_SCHED;
        }
        if (wr == 0) PG8_BAR;
        E(acc, cur, wr, wc, fr, fq);
        if (!has_next) break;
#pragma unroll
        for (int a = 0; a < 2; ++a)
#pragma unroll
            for (int b = 0; b < 2; ++b)
#pragma unroll
                for (int m = 0; m < 4; ++m)
#pragma unroll
                    for (int n = 0; n < 2; ++n) acc[a][b][m][n] = (f32x4){0.f, 0.f, 0.f, 0.f};
        cur = nxt; cA = nA; cB = nB; ++ui;
        if (wr == 1) PG8_BAR;
    }
    PG8_WAIT_V(0);
    PG8_BAR;
#undef PG8_SA
#undef PG8_SB
#undef PG8_STAGE
#undef PG8_LDA
#undef PG8_LDB
#undef PG8_MMA
#undef PG8_WAIT_V
#undef PG8_WAIT_L
#undef PG8_BAR
#undef PG8_SCHED
}
}
typedef f32x4 Acc[2][2][4][2];

struct EpiU {
    bf16_t* Ug;
    __device__ __forceinline__ void operator()(const Acc& acc, const pg8::Unit& u, int wr, int wc, int fr, int fq) const {
#pragma unroll
        for (int ai = 0; ai < 2; ++ai)
#pragma unroll
            for (int m = 0; m < 4; ++m) { const int row = u.pm * 256 + ai * 128 + wr * 64 + m * 16 + fr;
#pragma unroll
                for (int bj = 0; bj < 2; ++bj) { const int c0 = u.pn * 256 + bj * 128 + wc * 32 + 8 * fq; const int g = c0 >> 4, half = (c0 >> 3) & 1;
                    const f32x4 v0 = acc[ai][bj][m][0], v1 = acc[ai][bj][m][1]; u32x4 w;
                    w.x = pk2(v0[0], v0[1]); w.y = pk2(v0[2], v0[3]); w.z = pk2(v1[0], v1[1]); w.w = pk2(v1[2], v1[3]);
                    *(u32x4*)(Ug + ((size_t)g * M + row) * 16 + half * 8) = w; } }
    }
};
struct EpiGLU {
    const float* bias; const float* xres; const float* gvec; bf16_t* V;
    __device__ __forceinline__ void operator()(const Acc& acc, const pg8::Unit& u, int wr, int wc, int fr, int fq) const {
        const int b = u.pm >= 32; const int p0 = u.pn * 128 + wc * 32 + 8 * fq;
        f32x4 bv[2], bg[2], gg[2];
#pragma unroll
        for (int n = 0; n < 2; ++n) { bv[n] = *(const f32x4*)(bias + p0 + 4 * n); bg[n] = *(const f32x4*)(bias + D + p0 + 4 * n); gg[n] = *(const f32x4*)(gvec + (size_t)b * 6 * D + p0 + 4 * n) + 1.0f; }
#pragma unroll
        for (int ai = 0; ai < 2; ++ai)
#pragma unroll
            for (int m = 0; m < 4; ++m) { const size_t row = u.pm * 256 + ai * 128 + wr * 64 + m * 16 + fr;
                float o[8];
#pragma unroll
                for (int n = 0; n < 2; ++n) { const f32x4 val = acc[ai][0][m][n] + bv[n], gate = acc[ai][1][m][n] + bg[n]; const f32x4 xv = *(const f32x4*)(xres + row * D + p0 + 4 * n);
#pragma unroll
                    for (int e = 0; e < 4; ++e) o[4 * n + e] = ALPHA * xv[e] + gg[n][e] * (val[e] * sigmoidf_(gate[e])); }
                u32x4 w; w.x = pk2(o[0], o[1]); w.y = pk2(o[2], o[3]); w.z = pk2(o[4], o[5]); w.w = pk2(o[6], o[7]);
                *(u32x4*)(V + row * D + p0) = w; }
    }
};
struct EpiSwiGLU {
    bf16_t* ACT;
    __device__ __forceinline__ void operator()(const Acc& acc, const pg8::Unit& u, int wr, int wc, int fr, int fq) const {
        const int p0 = u.pn * 128 + wc * 32 + 8 * fq;
#pragma unroll
        for (int ai = 0; ai < 2; ++ai)
#pragma unroll
            for (int m = 0; m < 4; ++m) { const size_t row = u.pm * 256 + ai * 128 + wr * 64 + m * 16 + fr; float o[8];
#pragma unroll
                for (int n = 0; n < 2; ++n)
#pragma unroll
                    for (int e = 0; e < 4; ++e) { const float gv = acc[ai][0][m][n][e], uv = acc[ai][1][m][n][e]; o[4 * n + e] = gv * sigmoidf_(gv) * uv; }
                u32x4 w; w.x = pk2(o[0], o[1]); w.y = pk2(o[2], o[3]); w.z = pk2(o[4], o[5]); w.w = pk2(o[6], o[7]);
                *(u32x4*)(ACT + row * DFF + p0) = w; }
    }
};
struct EpiRes {
    const bf16_t* Vprev; const f32x2* stats; const float* lg; const float* lb; const float* gvec; bf16_t* V;
    __device__ __forceinline__ void operator()(const Acc& acc, const pg8::Unit& u, int wr, int wc, int fr, int fq) const {
        const int b = u.pm >= 32;
#pragma unroll
        for (int bj = 0; bj < 2; ++bj) { const int c = u.pn * 256 + bj * 128 + wc * 32 + 8 * fq;
            f32x4 gg[2], g4[2], b4[2];
#pragma unroll
            for (int n = 0; n < 2; ++n) { gg[n] = *(const f32x4*)(gvec + (size_t)b * 6 * D + c + 4 * n) + 1.0f; g4[n] = *(const f32x4*)(lg + c + 4 * n); b4[n] = *(const f32x4*)(lb + c + 4 * n); }
#pragma unroll
            for (int ai = 0; ai < 2; ++ai)
#pragma unroll
                for (int m = 0; m < 4; ++m) { const size_t row = u.pm * 256 + ai * 128 + wr * 64 + m * 16 + fr; const f32x2 st = stats[row];
                    const u32x4 pv = *(const u32x4*)(Vprev + row * D + c); float o[8];
#pragma unroll
                    for (int n = 0; n < 2; ++n)
#pragma unroll
                        for (int e = 0; e < 4; ++e) { const unsigned wd = pv[2 * n + (e >> 1)]; const float vp = __builtin_bit_cast(float, (e & 1) ? (wd & 0xffff0000u) : (wd << 16));
                            const float xv = (vp - st.x) * st.y * g4[n][e] + b4[n][e]; o[4 * n + e] = xv * ALPHA + gg[n][e] * acc[ai][bj][m][n][e]; }
                    u32x4 w; w.x = pk2(o[0], o[1]); w.y = pk2(o[2], o[3]); w.z = pk2(o[4], o[5]); w.w = pk2(o[6], o[7]);
                    *(u32x4*)(V + row * D + c) = w; } }
    }
};
struct EpiDSA {
    bf16_t *Q, *K, *Vt, *QI, *KI; float* WI; const f32x2* CSH; const f32x2* CSI;
    __device__ __forceinline__ void operator()(const Acc& acc, const pg8::Unit& u, int wr, int wc, int fr, int fq) const {
        const int pn = u.pn;
        if (pn < 16) {
            const int pl = wc * 32 + 8 * fq, hh = pl >> 6, d0 = pl & 63, head = 2 * (pn & 7) + hh; bf16_t* dst = pn < 8 ? Q : K; const float sc = pn < 8 ? QSCALE : 1.0f;
#pragma unroll
            for (int ai = 0; ai < 2; ++ai)
#pragma unroll
                for (int m = 0; m < 4; ++m) { const size_t row = u.pm * 256 + ai * 128 + wr * 64 + m * 16 + fr; float o1[8], o2[8];
#pragma unroll
                    for (int n = 0; n < 2; ++n)
#pragma unroll
                        for (int e = 0; e < 4; ++e) { const f32x2 cs = CSH[row * 64 + d0 + 4 * n + e]; const float a = acc[ai][0][m][n][e], bb = acc[ai][1][m][n][e];
                            o1[4 * n + e] = (a * cs.x - bb * cs.y) * sc; o2[4 * n + e] = (bb * cs.x + a * cs.y) * sc; }
                    u32x4 w1, w2; w1.x = pk2(o1[0], o1[1]); w1.y = pk2(o1[2], o1[3]); w1.z = pk2(o1[4], o1[5]); w1.w = pk2(o1[6], o1[7]);
                    w2.x = pk2(o2[0], o2[1]); w2.y = pk2(o2[2], o2[3]); w2.z = pk2(o2[4], o2[5]); w2.w = pk2(o2[6], o2[7]);
                    bf16_t* p = dst + row * D + head * 128 + d0; *(u32x4*)p = w1; *(u32x4*)(p + 64) = w2; }
        } else if (pn < 24) {
#pragma unroll
            for (int ai = 0; ai < 2; ++ai)
#pragma unroll
                for (int m = 0; m < 4; ++m) { const int row = u.pm * 256 + ai * 128 + wr * 64 + m * 16 + fr; const int b = row >> 13, t = row & (SEQ - 1); const int tp = (t & ~15) | ((((t >> 2) & 1) << 1 | ((t >> 3) & 1)) << 2) | (t & 3);
#pragma unroll
                    for (int bj = 0; bj < 2; ++bj)
#pragma unroll
                        for (int n = 0; n < 2; ++n)
#pragma unroll
                            for (int e = 0; e < 4; ++e) { const int c = (pn - 16) * 256 + bj * 128 + wc * 32 + 8 * fq + 4 * n + e; const int head = c >> 7, d = c & 127;
                                Vt[((size_t)((b * 16 + head) * 128 + d)) * SEQ + tp] = (bf16_t)f2bf(acc[ai][bj][m][n][e]); } }
        } else if (pn < 28) {
            const int ih = 4 * (pn - 24) + wc, d0 = 8 * fq;
#pragma unroll
            for (int ai = 0; ai < 2; ++ai)
#pragma unroll
                for (int m = 0; m < 4; ++m) { const size_t row = u.pm * 256 + ai * 128 + wr * 64 + m * 16 + fr; float o1[8], o2[8];
#pragma unroll
                    for (int n = 0; n < 2; ++n)
#pragma unroll
                        for (int e = 0; e < 4; ++e) { const f32x2 cs = CSI[row * 32 + d0 + 4 * n + e]; const float a = acc[ai][0][m][n][e], bb = acc[ai][1][m][n][e];
                            o1[4 * n + e] = (a * cs.x - bb * cs.y) * 0.125f; o2[4 * n + e] = (bb * cs.x + a * cs.y) * 0.125f; }
                    u32x4 w1, w2; w1.x = pk2(o1[0], o1[1]); w1.y = pk2(o1[2], o1[3]); w1.z = pk2(o1[4], o1[5]); w1.w = pk2(o1[6], o1[7]);
                    w2.x = pk2(o2[0], o2[1]); w2.y = pk2(o2[2], o2[3]); w2.z = pk2(o2[4], o2[5]); w2.w = pk2(o2[6], o2[7]);
                    bf16_t* p = QI + row * 1024 + ih * 64 + d0; *(u32x4*)p = w1; *(u32x4*)(p + 32) = w2; }
        } else {
            if (wc == 0) {
                const int d0 = 8 * fq;
#pragma unroll
                for (int ai = 0; ai < 2; ++ai)
#pragma unroll
                    for (int m = 0; m < 4; ++m) { const size_t row = u.pm * 256 + ai * 128 + wr * 64 + m * 16 + fr; float o1[8], o2[8];
#pragma unroll
                        for (int n = 0; n < 2; ++n)
#pragma unroll
                            for (int e = 0; e < 4; ++e) { const f32x2 cs = CSI[row * 32 + d0 + 4 * n + e]; const float a = acc[ai][0][m][n][e], bb = acc[ai][1][m][n][e];
                                o1[4 * n + e] = a * cs.x - bb * cs.y; o2[4 * n + e] = bb * cs.x + a * cs.y; }
                        u32x4 w1, w2; w1.x = pk2(o1[0], o1[1]); w1.y = pk2(o1[2], o1[3]); w1.z = pk2(o1[4], o1[5]); w1.w = pk2(o1[6], o1[7]);
                        w2.x = pk2(o2[0], o2[1]); w2.y = pk2(o2[2], o2[3]); w2.z = pk2(o2[4], o2[5]); w2.w = pk2(o2[6], o2[7]);
                        bf16_t* p = KI + row * 64 + d0; *(u32x4*)p = w1; *(u32x4*)(p + 32) = w2; }
            } else if (wc == 1 && fq < 2) {
#pragma unroll
                for (int ai = 0; ai < 2; ++ai)
#pragma unroll
                    for (int m = 0; m < 4; ++m) { const size_t row = u.pm * 256 + ai * 128 + wr * 64 + m * 16 + fr;
#pragma unroll
                        for (int n = 0; n < 2; ++n) *(f32x4*)(WI + row * 16 + 8 * fq + 4 * n) = acc[ai][0][m][n] * 0.25f; }
            }
        }
    }
};

__device__ __forceinline__ int dest_row(int mode, int n) {
    if (mode == 0) return n;
    if (mode == 1) { const int s = n >= 2048, p = n - s * 2048; return 256 * (p >> 7) + 128 * s + (p & 127); }
    if (mode == 2) { const int s = n >= DFF, p = n - s * DFF; return 256 * (p >> 7) + 128 * s + (p & 127); }
    if (n < 4096) { const int blk = n >> 11, w = n & 2047, head = w >> 7, e = w & 127, s = e >> 6, d = e & 63; return blk * 2048 + 256 * (head >> 1) + 128 * s + 64 * (head & 1) + d; }
    if (n < 6144) return n;
    if (n < 7168) { const int mm = n - 6144, ih = mm >> 6, e = mm & 63, s = e >> 5, d = e & 31; return 6144 + 256 * (ih >> 2) + 128 * s + 32 * (ih & 3) + d; }
    if (n < 7184) return 7168 + 32 + (n - 7168);
    { const int mm = n - 7184, s = mm >> 5, d = mm & 31; return 7168 + 128 * s + d; }
}
__device__ __forceinline__ void transpose_item(const float* W, int K, int N, bf16_t* WT, int mode, LAS float* scr, int item, int lane) {
    const int nblk = (N + 31) / 32, kb = item / nblk, nb = item % nblk, k0 = 64 * kb, n0 = 32 * nb;
    const int nn = n0 + (lane & 31); const bool okn = nn < N;
    float tv[32];
#pragma unroll
    for (int i = 0; i < 32; ++i) { const int kk = 2 * i + (lane >> 5); tv[i] = okn ? W[(size_t)(k0 + kk) * N + nn] : 0.f; }
#pragma unroll
    for (int i = 0; i < 32; ++i) { const int kk = 2 * i + (lane >> 5); scr[kk * 33 + (lane & 31)] = tv[i]; }
    asm volatile("s_waitcnt lgkmcnt(0)" ::: "memory");
    const int c = lane & 7;
#pragma unroll
    for (int j = 0; j < 4; ++j) { const int n = (lane >> 3) + 8 * j; const LAS float* s = scr + (8 * c) * 33 + n;
        u32x4 o; o.x = pk2(s[0 * 33], s[1 * 33]); o.y = pk2(s[2 * 33], s[3 * 33]); o.z = pk2(s[4 * 33], s[5 * 33]); o.w = pk2(s[6 * 33], s[7 * 33]);
        if (n0 + n < N) *(u32x4*)(WT + (size_t)dest_row(mode, n0 + n) * K + k0 + 8 * c) = o; }
    asm volatile("s_waitcnt lgkmcnt(0)" ::: "memory");
}

__device__ __forceinline__ void mod_item(const Params& P, int item, LAS float* lds) {
    const int tid = threadIdx.x; const int layer = item / 96, cb = item % 96;
    LAS float* cact = lds;
    LAS float* red = lds + 4096;
    for (int i = tid; i < 2 * D; i += NTHR) { const float v = P.c[i]; cact[i] = v * sigmoidf_(v); }
    __syncthreads();
    const int cq = tid & 31, ks = tid >> 5; const int col = cb * 128 + cq * 4;
    const float* W = P.ada_w + (size_t)layer * D * 6 * D + col;
    f32x4 a0 = {0.f, 0.f, 0.f, 0.f}, a1 = {0.f, 0.f, 0.f, 0.f};
#pragma unroll 16
    for (int k = ks * 128; k < ks * 128 + 128; ++k) { const f32x4 w = *(const f32x4*)(W + (size_t)k * 6 * D); a0 += w * cact[k]; a1 += w * cact[D + k]; }
    *(LAS f32x4*)(red + (ks * 2 + 0) * 128 + cq * 4) = a0; *(LAS f32x4*)(red + (ks * 2 + 1) * 128 + cq * 4) = a1;
    __syncthreads();
    if (tid < 256) { const int b = tid >> 7, cc = tid & 127; float s = P.ada_b[layer * 6 * D + cb * 128 + cc];
#pragma unroll
        for (int k = 0; k < 16; ++k) s += red[(k * 2 + b) * 128 + cc];
        ((float*)(P.ws + OFF_MOD))[(size_t)(layer * 2 + b) * 6 * D + cb * 128 + cc] = s; }
    __syncthreads();
}

__device__ __forceinline__ void s5_table_item(const Params& P, int g, LAS float* lds) {
    const int tid = threadIdx.x;
    LAS f32x2* pw = (LAS f32x2*)lds;
    LAS f32x2* bb = pw + 33 * 64;
    LAS f32x2* cc = bb + 64 * 16;
    {
        const double dt = exp((double)P.log_dt[g]);
#pragma unroll 1
        for (int idx = tid; idx < 33 * 64; idx += NTHR) { const int k = idx >> 6, n = idx & 63;
            const double zre = (double)P.a_re[g * 64 + n] * dt, zim = (double)P.a_im[g * 64 + n] * dt;
            const float mag = (float)exp(zre * k); float sn, cs; sincos_rev(zim * k * 0.15915494309189535, sn, cs); pw[k * 64 + n] = (f32x2){mag * cs, mag * sn}; }
    }
    __syncthreads();
#pragma unroll 1
    for (int i = tid; i < 64 * 16; i += NTHR) { const int n = i >> 4;
        const float are = P.a_re[g * 64 + n], aim = P.a_im[g * 64 + n]; const f32x2 lb = pw[64 + n];
        const float nr = lb.x - 1.0f, ni = lb.y, den = are * are + aim * aim;
        const float fr_ = (nr * are + ni * aim) / den, fi_ = (ni * are - nr * aim) / den;
        const float br = P.b_re[(size_t)g * 1024 + i], bi = P.b_im[(size_t)g * 1024 + i];
        bb[i] = (f32x2){fr_ * br - fi_ * bi, fr_ * bi + fi_ * br};
        cc[i] = (f32x2){P.c_re[(size_t)g * 1024 + i], P.c_im[(size_t)g * 1024 + i]}; }
    __syncthreads();
    bf16_t* WE = (bf16_t*)(P.ws + OFF_WE) + (size_t)g * 128 * 512;
    bf16_t* WP = (bf16_t*)(P.ws + OFF_WP) + (size_t)g * 512 * 128;
    bf16_t* KM = (bf16_t*)(P.ws + OFF_KM) + (size_t)g * 32 * 256;
#pragma unroll 2
    for (int idx = tid; idx < 128 * 512; idx += NTHR) { const int np = idx >> 9, jp = idx & 511, j = jp >> 4, p = jp & 15, n = np & 63;
        const f32x2 l = pw[(31 - j) * 64 + n], b = bb[n * 16 + p]; const float re = l.x * b.x - l.y * b.y, im = l.x * b.y + l.y * b.x;
        WE[idx] = (bf16_t)f2bf(np < 64 ? re : im); }
#pragma unroll 2
    for (int idx = tid; idx < 512 * 128; idx += NTHR) { const int jp = idx >> 7, np = idx & 127, j = jp >> 4, p = jp & 15, n = np & 63;
        const f32x2 l = pw[(j + 1) * 64 + n], c = cc[p * 64 + n]; const float re = l.x * c.x - l.y * c.y, im = l.x * c.y + l.y * c.x;
        WP[idx] = (bf16_t)f2bf(np < 64 ? re : -im); }
#pragma unroll 1
    for (int idx = tid; idx < 32 * 256; idx += NTHR) { const int tau = idx >> 8, p = (idx >> 4) & 15, q = idx & 15; float s = 0.f;
#pragma unroll 4
        for (int n = 0; n < 64; ++n) { const f32x2 l = pw[tau * 64 + n], c = cc[p * 64 + n], b = bb[n * 16 + q];
            const float tr = c.x * l.x - c.y * l.y, ti = c.x * l.y + c.y * l.x; s += tr * b.x - ti * b.y; }
        KM[idx] = (bf16_t)f2bf(s); }
    if (tid < 64) ((f32x2*)(P.ws + OFF_LAMT))[g * 64 + tid] = pw[32 * 64 + tid];
    __syncthreads();
}

__device__ __forceinline__ void rope_item(const Params& P, int item, int lane) {
    f32x2* CSH = (f32x2*)(P.ws + OFF_CSH); f32x2* CSI = (f32x2*)(P.ws + OFF_CSI);
    const float invh = 1.0f / powf(10000.0f, (float)(2 * lane) / 128.0f);
    const float invi = 1.0f / powf(10000.0f, (float)(2 * (lane & 31)) / 64.0f);
    for (int r = 0; r < 64; ++r) { const int row = item * 64 + r; const float pos = (float)P.pos[row];
        { const float ang = pos * invh; float s, c; sincos_rev((double)ang * 0.15915494309189535, s, c); CSH[(size_t)row * 64 + lane] = (f32x2){c, s}; }
        if (lane < 32) { const float ang = pos * invi; float s, c; sincos_rev((double)ang * 0.15915494309189535, s, c); CSI[(size_t)row * 32 + lane] = (f32x2){c, s}; } }
}

#define RP_IDX(j) (MODE == 0 ? (lane + 64 * (j)) : (2 * (lane + 64 * ((j) >> 1)) + ((j) & 1)))
template <int MODE>
__device__ __forceinline__ void row_load(f32x4 (&v)[8], const void* src, int m, int lane) {
    if (MODE == 0) { const f32x4* xr = (const f32x4*)((const float*)src + (size_t)m * D) + lane;
#pragma unroll
        for (int j = 0; j < 8; ++j) v[j] = xr[64 * j]; }
    else { const u32x4* xr = (const u32x4*)((const bf16_t*)src + (size_t)m * D) + lane;
#pragma unroll
        for (int j = 0; j < 4; ++j) { const u32x4 p = xr[64 * j];
            v[2 * j] = (f32x4){__builtin_bit_cast(float, p.x << 16), __builtin_bit_cast(float, p.x & 0xffff0000u), __builtin_bit_cast(float, p.y << 16), __builtin_bit_cast(float, p.y & 0xffff0000u)};
            v[2 * j + 1] = (f32x4){__builtin_bit_cast(float, p.z << 16), __builtin_bit_cast(float, p.z & 0xffff0000u), __builtin_bit_cast(float, p.w << 16), __builtin_bit_cast(float, p.w & 0xffff0000u)}; } }
}
template <int MODE>
__device__ __forceinline__ void row_finish(f32x4 (&v)[8], int m, int lane, const float* lg, const float* lb, const float* sc, const float* sh, float* Xout, bf16_t* HB) {
    const int b = m >> 13;
    if (MODE != 0) {
        float s = 0.f;
#pragma unroll
        for (int j = 0; j < 8; ++j) s += (v[j].x + v[j].y) + (v[j].z + v[j].w);
        const float mean = wave_sum(s) * (1.f / D); float s2 = 0.f;
#pragma unroll
        for (int j = 0; j < 8; ++j) { v[j] = v[j] - mean; s2 += (v[j].x * v[j].x + v[j].y * v[j].y) + (v[j].z * v[j].z + v[j].w * v[j].w); }
        const float rstd = 1.f / sqrtf(wave_sum(s2) * (1.f / D) + LN_EPS);
#pragma unroll
        for (int j = 0; j < 8; ++j) { const f32x4 gg = *((const f32x4*)lg + RP_IDX(j)), bb = *((const f32x4*)lb + RP_IDX(j)); v[j] = v[j] * rstd * gg + bb;
            if (MODE == 2) *((f32x4*)(Xout + (size_t)m * D) + RP_IDX(j)) = v[j]; }
        if (MODE == 1 && lane == 0) ((f32x2*)Xout)[m] = (f32x2){mean, rstd};
    }
    if (MODE != 2) {
#pragma unroll
        for (int j = 0; j < 8; ++j) { const f32x4 s1 = *((const f32x4*)(sc + (size_t)b * 6 * D) + RP_IDX(j)) + 1.0f, s0 = *((const f32x4*)(sh + (size_t)b * 6 * D) + RP_IDX(j));
            const f32x4 h = v[j] * s1 + s0; u32x2 w; w.x = pk2(h.x, h.y); w.y = pk2(h.z, h.w);
            *((u32x2*)(HB + (size_t)m * D) + RP_IDX(j)) = w; }
    }
}
template <int MODE>
__device__ __forceinline__ void row_pass(const void* src, const float* lg, const float* lb, const float* sc, const float* sh, float* Xout, bf16_t* HB, int G) {
    const int lane = threadIdx.x & 63, wave = threadIdx.x >> 6; const int gw = blockIdx.x * NW + wave, NGW = G * NW;
    for (int m = gw; m < M; m += 2 * NGW) {
        const int m2 = m + NGW; const bool has2 = m2 < M;
        f32x4 va[8], vb[8];
        row_load<MODE>(va, src, m, lane);
        if (has2) row_load<MODE>(vb, src, m2, lane);
        row_finish<MODE>(va, m, lane, lg, lb, sc, sh, Xout, HB);
        if (has2) row_finish<MODE>(vb, m2, lane, lg, lb, sc, sh, Xout, HB);
    }
}
#undef RP_IDX

__device__ __forceinline__ float gelu_tanh(float x) { const float z = 0.7978845608028654f * (x + 0.044715f * x * x * x); return x * __builtin_amdgcn_rcpf(1.0f + __expf(-2.0f * z)); }
__device__ __forceinline__ void s5_item(const Params& P, int g, int b, LAS unsigned char* ldsb) {
    const int tid = threadIdx.x, lane = tid & 63, w = tid >> 6, r32 = lane & 31, hh = lane >> 5;
    LAS float* E = (LAS float*)ldsb;
    const bf16_t* Ug = (const bf16_t*)(P.ws + OFF_UG) + ((size_t)g * M + (size_t)b * SEQ) * 16;
    const bf16_t* WE = (const bf16_t*)(P.ws + OFF_WE) + (size_t)g * 128 * 512;
    const bf16_t* WP = (const bf16_t*)(P.ws + OFF_WP) + (size_t)g * 512 * 128;
    const bf16_t* KM = (const bf16_t*)(P.ws + OFF_KM) + (size_t)g * 32 * 256;
    bf16_t* Gout = (bf16_t*)(P.ws + OFF_G);
    const int c = 32 * w + r32;
    const bf16_t* ucol = Ug + (size_t)c * CH_T * 16 + 8 * hh;
    {
        f32x16 acc[4];
#pragma unroll
        for (int rb = 0; rb < 4; ++rb)
#pragma unroll
            for (int i = 0; i < 16; ++i) acc[rb][i] = 0.f;
#pragma unroll 4
        for (int ks = 0; ks < 32; ++ks) {
            const bf16x8 bf = *(const bf16x8*)(ucol + ks * 16);
#pragma unroll
            for (int rb = 0; rb < 4; ++rb) { const bf16x8 af = *(const bf16x8*)(WE + (size_t)(32 * rb + r32) * 512 + 16 * ks + 8 * hh); acc[rb] = mfma32(af, bf, acc[rb]); }
        }
#pragma unroll
        for (int rb = 0; rb < 4; ++rb)
#pragma unroll
            for (int i = 0; i < 4; ++i) *(LAS f32x4*)(E + c * ESTR + 32 * rb + 8 * i + 4 * hh) = (f32x4){acc[rb][4 * i], acc[rb][4 * i + 1], acc[rb][4 * i + 2], acc[rb][4 * i + 3]};
    }
    __syncthreads();
    if (w == 0) {
        const f32x2 lt = ((const f32x2*)(P.ws + OFF_LAMT))[g * 64 + lane]; float sr = 0.f, si = 0.f;
        for (int cc = 0; cc < NCH; ++cc) {
            const float er = E[cc * ESTR + lane], ei = E[cc * ESTR + 64 + lane];
            __builtin_amdgcn_wave_barrier();
            LAS bf16_t* pp = (LAS bf16_t*)(E + cc * ESTR); pp[lane] = (bf16_t)f2bf(sr); pp[64 + lane] = (bf16_t)f2bf(si);
            const float nr = lt.x * sr - lt.y * si + er, ni = lt.x * si + lt.y * sr + ei; sr = nr; si = ni;
        }
    }
    __syncthreads();
    {
        bf16x8 pf[8];
#pragma unroll
        for (int ks = 0; ks < 8; ++ks) pf[ks] = *(const LAS bf16x8*)((LAS unsigned char*)(E + c * ESTR) + 32 * ks + 16 * hh);
        const int jr = r32 >> 4, pr = r32 & 15;
        for (int Jg = 0; Jg < 4; ++Jg) {
            f32x16 acc[4];
#pragma unroll
            for (int jb = 0; jb < 4; ++jb)
#pragma unroll
                for (int i = 0; i < 16; ++i) acc[jb][i] = 0.f;
#pragma unroll
            for (int jb = 0; jb < 4; ++jb) { const int J = 4 * Jg + jb;
#pragma unroll
                for (int ks = 0; ks < 8; ++ks) { const bf16x8 af = *(const bf16x8*)(WP + (size_t)(32 * J + r32) * 128 + 16 * ks + 8 * hh); acc[jb] = mfma32(af, pf[ks], acc[jb]); } }
            const int imax = 8 * Jg + 7;
            for (int i = 0; i <= imax; ++i) {
                const bf16x8 bf = *(const bf16x8*)(ucol + i * 16);
#pragma unroll
                for (int jb = 0; jb < 4; ++jb) { const int J = 4 * Jg + jb;
                    if (i <= 2 * J + 1) { const int tau = 2 * J + jr - i; bf16x8 af = {0, 0, 0, 0, 0, 0, 0, 0};
                        if (tau >= 0) af = *(const bf16x8*)(KM + (size_t)tau * 256 + pr * 16 + 8 * hh);
                        acc[jb] = mfma32(af, bf, acc[jb]); } }
            }
#pragma unroll
            for (int jb = 0; jb < 4; ++jb) { const int J = 4 * Jg + jb;
#pragma unroll
                for (int i4 = 0; i4 < 4; ++i4) { const int jj = i4 >> 1, p0 = 8 * (i4 & 1) + 4 * hh; const int tok = c * CH_T + 2 * J + jj; const int ch0 = g * 16 + p0;
                    const u32x2 uu = *(const u32x2*)(Ug + (size_t)tok * 16 + p0); const f32x4 dsk = *(const f32x4*)(P.s5_d + ch0);
                    const float u0 = __builtin_bit_cast(float, uu.x << 16), u1 = __builtin_bit_cast(float, uu.x & 0xffff0000u), u2 = __builtin_bit_cast(float, uu.y << 16), u3 = __builtin_bit_cast(float, uu.y & 0xffff0000u);
                    const float y0 = gelu_tanh(acc[jb][4 * i4] + dsk.x * u0), y1 = gelu_tanh(acc[jb][4 * i4 + 1] + dsk.y * u1), y2 = gelu_tanh(acc[jb][4 * i4 + 2] + dsk.z * u2), y3 = gelu_tanh(acc[jb][4 * i4 + 3] + dsk.w * u3);
                    u32x2 o; o.x = pk2(y0, y1); o.y = pk2(y2, y3);
                    *(u32x2*)(Gout + ((size_t)b * SEQ + tok) * D + ch0) = o; } }
        }
    }
    __syncthreads();
}

__device__ __forceinline__ unsigned ordkey(float f) { const unsigned u = __builtin_bit_cast(unsigned, f); return (u & 0x80000000u) ? ~u : (u | 0x80000000u); }
#define LDS_ADD1(p) ((void)__hip_atomic_fetch_add((p), 1u, __ATOMIC_RELAXED, __HIP_MEMORY_SCOPE_WORKGROUP))
template <int NB>
__device__ __forceinline__ void radix_pass(const float* s, int n, int nch, int shift, int hshift, unsigned hval, LAS unsigned* hist, int lane, unsigned& K, unsigned& binout) {
    constexpr int BPL = NB / 64;
#pragma unroll
    for (int j = 0; j < BPL; ++j) hist[lane + 64 * j] = 0u;
    __builtin_amdgcn_wave_barrier();
#pragma unroll 1
    for (int base = 0; base < nch; base += 16) {
        float v[16];
#pragma unroll
        for (int j = 0; j < 16; ++j) { const int i = 64 * (base + j) + lane; v[j] = (i < n) ? s[i] : __builtin_nanf(""); }
#pragma unroll
        for (int j = 0; j < 16; ++j) { const int i = 64 * (base + j) + lane; const unsigned kk = ordkey(v[j]); const bool ok = (i < n) && ((hshift >= 32) || ((kk >> hshift) == hval));
            if (ok) LDS_ADD1(hist + ((kk >> shift) & (NB - 1))); }
    }
    __builtin_amdgcn_wave_barrier();
    asm volatile("s_waitcnt lgkmcnt(0)" ::: "memory");
    unsigned sl = 0;
#pragma unroll
    for (int j = 0; j < BPL; ++j) sl += hist[lane * BPL + j];
    unsigned inc = sl;
#pragma unroll
    for (int off = 1; off < 64; off <<= 1) { const unsigned t = __shfl_down(inc, off); if (lane + off < 64) inc += t; }
    const unsigned above = inc - sl;
    const bool mine = (above < K) && (K <= inc);
    unsigned bin = 0, krem = 0;
    if (mine) { unsigned cum = above; bool found = false;
        for (int j = BPL - 1; j >= 0; --j) { const unsigned cnt = hist[lane * BPL + j]; if (!found && cum + cnt >= K) { found = true; bin = lane * BPL + j; krem = K - cum; } cum += cnt; } }
    const unsigned long long bm = __ballot(mine); const int src = bm ? (__ffsll((long long)bm) - 1) : 0;
    binout = __shfl(bin, src); K = __shfl(krem, src);
    __builtin_amdgcn_wave_barrier();
}
__device__ __forceinline__ void select_query(const float* s, int b, int t, LAS unsigned* hist, int lane, unsigned long long* MASK) {
    const int n = t + 1; const int nch_tot = ((t >> 8) + 1) * 4; const int nch = (n + 63) >> 6;
    unsigned long long* mp = MASK + (size_t)b * 128 * SEQ + t;
    if (n <= 256) {
        for (int ch = 0; ch < nch_tot; ++ch) { const int i = 64 * ch + lane; const unsigned long long wd = __ballot(i < n); if (lane == 0) mp[(size_t)ch * SEQ] = wd; }
        return;
    }
    unsigned K = 256, b1, b2, b3;
    radix_pass<2048>(s, n, nch, 21, 32, 0u, hist, lane, K, b1);
    radix_pass<2048>(s, n, nch, 10, 21, b1, hist, lane, K, b2);
    radix_pass<1024>(s, n, nch, 0, 10, (b1 << 11) | b2, hist, lane, K, b3);
    const unsigned T = (b1 << 21) | (b2 << 10) | b3; unsigned running = 0;
#pragma unroll 1
    for (int base = 0; base < nch_tot; base += 16) {
        float v[16];
#pragma unroll
        for (int j = 0; j < 16; ++j) { const int i = 64 * (base + j) + lane; v[j] = (i < n) ? s[i] : __builtin_nanf(""); }
#pragma unroll
        for (int j = 0; j < 16; ++j) { const int i = 64 * (base + j) + lane; const unsigned kk = ordkey(v[j]); const bool valid = i < n;
            const bool gt = valid && kk > T, eq = valid && kk == T; const unsigned long long em = __ballot(eq);
            const unsigned rank = running + (unsigned)__popcll(em & ((1ull << lane) - 1ull));
            const unsigned long long wd = __ballot(gt || (eq && rank < K)); if (lane == 0 && base + j < nch_tot) mp[(size_t)(base + j) * SEQ] = wd; running += (unsigned)__popcll(em); }
    }
}
constexpr int IX_SK = 256, IX_RSTR = 144, IX_STAGE = IX_SK * IX_RSTR;
__device__ __forceinline__ float relu_asm(float x) { return __builtin_amdgcn_fmed3f(x, 0.f, __builtin_inff()); }
__device__ __forceinline__ void indexer_block(const Params& P, int b, int blk, LAS unsigned char* ldsb) {
    const int tid = threadIdx.x, lane = tid & 63, w = tid >> 6, r32 = lane & 31, hh = lane >> 5;
    const bf16_t* QI = (const bf16_t*)(P.ws + OFF_QI); const bf16_t* KI = (const bf16_t*)(P.ws + OFF_KI); const float* WI = (const float*)(P.ws + OFF_WI);
    float* scr = (float*)(P.ws + OFF_SCR) + (size_t)blockIdx.x * 16 * SEQ;
    const int t0 = 16 * blk; const int qq = r32 >> 4, head = r32 & 15;
    const size_t qrow = (size_t)b * SEQ + t0 + 2 * w;
    bf16x8 af[4];
#pragma unroll
    for (int ks = 0; ks < 4; ++ks) af[ks] = *(const bf16x8*)(QI + (qrow + qq) * 1024 + head * 64 + 16 * ks + 8 * hh);
    f32x4 wv[2][2];
#pragma unroll
    for (int q2 = 0; q2 < 2; ++q2) { wv[q2][0] = *(const f32x4*)(WI + (qrow + q2) * 16 + 4 * hh); wv[q2][1] = *(const f32x4*)(WI + (qrow + q2) * 16 + 8 + 4 * hh); }
    const int nt = (t0 + 16 + 31) >> 5;
    const int nst = (nt + 7) >> 3;
    float* srow = scr + (size_t)(2 * w + hh) * SEQ + r32;
    const bf16_t* kg = KI + (size_t)b * SEQ * 64;
    u32x4 rg[4];
#define IX_GLOAD(st) do { _Pragma("unroll") for (int i = 0; i < 4; ++i) { const int idx = tid + 512 * i; rg[i] = *(const u32x4*)(kg + ((size_t)(st) * IX_SK + (idx >> 3)) * 64 + 8 * (idx & 7)); } } while (0)
#define IX_LWRITE(buf) do { _Pragma("unroll") for (int i = 0; i < 4; ++i) { const int idx = tid + 512 * i; *(LAS u32x4*)(ldsb + (buf) * IX_STAGE + (idx >> 3) * IX_RSTR + 16 * (idx & 7)) = rg[i]; } } while (0)
#ifndef IX_REP
#define IX_REP 1
#endif
    for (int rep_ = 0; rep_ < IX_REP; ++rep_) {
    __syncthreads();
    IX_GLOAD(0); IX_LWRITE(0);
    __syncthreads();
    for (int st = 0; st < nst; ++st) {
        if (st + 1 < nst) IX_GLOAD(st + 1);
        const LAS unsigned char* kb = ldsb + (st & 1) * IX_STAGE + r32 * IX_RSTR + 16 * hh;
#pragma unroll
        for (int jg = 0; jg < 2; ++jg) {
            if (8 * st + 4 * jg < nt) {
                f32x16 acc[4];
#pragma unroll
                for (int j = 0; j < 4; ++j)
#pragma unroll
                    for (int i = 0; i < 16; ++i) acc[j][i] = 0.f;
#pragma unroll
                for (int ks = 0; ks < 4; ++ks)
#pragma unroll
                    for (int j = 0; j < 4; ++j) { const bf16x8 bf = *(const LAS bf16x8*)(kb + (4 * jg + j) * 32 * IX_RSTR + 32 * ks); acc[j] = mfma32(af[ks], bf, acc[j]); }
                float mine[4];
#pragma unroll
                for (int j = 0; j < 4; ++j) { float p0 = 0.f, p1 = 0.f;
#pragma unroll
                    for (int i = 0; i < 4; ++i) { p0 += wv[0][0][i] * relu_asm(acc[j][i]) + wv[0][1][i] * relu_asm(acc[j][4 + i]); p1 += wv[1][0][i] * relu_asm(acc[j][8 + i]) + wv[1][1][i] * relu_asm(acc[j][12 + i]); }
                    const float send = hh ? p0 : p1; mine[j] = (hh ? p1 : p0); acc[j][0] = send; }
#pragma unroll
                for (int j = 0; j < 4; ++j) { const float recv = __shfl_xor(acc[j][0], 32); const int kt = 8 * st + 4 * jg + j; if (kt < nt) srow[32 * kt] = mine[j] + recv; }
            } }
        if (st + 1 < nst) IX_LWRITE((st + 1) & 1);
        __syncthreads();
    }
    }
#undef IX_GLOAD
#undef IX_LWRITE
    asm volatile("s_waitcnt vmcnt(0)" ::: "memory");
    __builtin_amdgcn_fence(__ATOMIC_ACQUIRE, "agent");
    asm volatile("s_waitcnt vmcnt(0)" ::: "memory");
    LAS unsigned* hist = (LAS unsigned*)(ldsb + 2 * IX_STAGE) + w * 2048;
    unsigned long long* MASK = (unsigned long long*)(P.ws + OFF_MASK);
    select_query(scr + (size_t)(2 * w) * SEQ, b, t0 + 2 * w, hist, lane, MASK);
    select_query(scr + (size_t)(2 * w + 1) * SEQ, b, t0 + 2 * w + 1, hist, lane, MASK);
}

constexpr int ATT_STAGE = 32768, ATT_VOFF = 16384, ATT_NS = 4;
__device__ __forceinline__ unsigned cvtpk(float lo, float hi) { f32x2 v = {lo, hi}; bf16x2_t b = __builtin_convertvector(v, bf16x2_t); return __builtin_bit_cast(unsigned, b); }
__device__ __forceinline__ void attn_unit(const Params& P, int b, int h, int qb, bool desc, LAS unsigned char* ldsb) {
    const int tid = threadIdx.x, lane = tid & 63, w = __builtin_amdgcn_readfirstlane(tid >> 6), r32 = lane & 31, hh = lane >> 5;
    const bf16_t* Q = (const bf16_t*)(P.ws + OFF_Q); const bf16_t* Kg = (const bf16_t*)(P.ws + OFF_K); const bf16_t* Vt = (const bf16_t*)(P.ws + OFF_VT);
    const unsigned long long* MASK = (const unsigned long long*)(P.ws + OFF_MASK);
    const int q0 = qb * 256; const size_t qrow = (size_t)b * SEQ + q0 + 32 * w + r32;
    const int NT = 4 * qb + 4;
    const bf16_t* Kbase = Kg + ((size_t)b * SEQ) * D + h * 128;
    const bf16_t* Vbase = Vt + ((size_t)(b * 16 + h) * 128) * SEQ;
    const unsigned* mrow32 = (const unsigned*)(MASK + (size_t)b * 128 * SEQ + q0 + 32 * w) + lane;
    constexpr int ATT_MOFF = ATT_NS * ATT_STAGE;
    unsigned ksrc[2], vsrc[2];
#pragma unroll
    for (int i = 0; i < 2; ++i) { const int ki = 2 * w + i; const int krow = 4 * ki + (lane >> 4), kch = (lane & 15) ^ (krow & 15); ksrc[i] = (unsigned)(krow * D + 8 * kch);
        const int vrow = 8 * ki + (lane >> 3), vch = (lane & 7) ^ ((vrow >> 1) & 7); vsrc[i] = (unsigned)(vrow * SEQ + 8 * vch); }
#define AT_DMA(tt, slot) do { _Pragma("unroll") for (int i = 0; i < 2; ++i) { \
        __builtin_amdgcn_global_load_lds((const unsigned*)(Kbase + (size_t)(tt) * 64 * D + ksrc[i]), (LAS unsigned*)(ldsb + (slot) * ATT_STAGE + (2 * w + i) * 1024), 16, 0, 0); \
        __builtin_amdgcn_global_load_lds((const unsigned*)(Vbase + (size_t)(tt) * 64 + vsrc[i]), (LAS unsigned*)(ldsb + (slot) * ATT_STAGE + ATT_VOFF + (2 * w + i) * 1024), 16, 0, 0); } \
        __builtin_amdgcn_global_load_lds(mrow32 + (size_t)(tt) * SEQ * 2, (LAS unsigned*)(ldsb + ATT_MOFF + (slot) * 2048 + w * 256), 4, 0, 0); } while (0)
    const int kbase0 = r32 * 256 + 16 * (hh ^ (r32 & 15));
    const int vbase0 = ATT_VOFF + r32 * 128 + 16 * (hh ^ ((r32 >> 1) & 7));
    asm volatile("s_waitcnt vmcnt(0) lgkmcnt(0)\n\ts_barrier" ::: "memory");
    bf16x8 qf[8];
#pragma unroll
    for (int ks = 0; ks < 8; ++ks) qf[ks] = *(const bf16x8*)(Q + qrow * D + h * 128 + 16 * ks + 8 * hh);
#define AT_TILE(i) (desc ? (NT - 1 - (i)) : (i))
    AT_DMA(AT_TILE(0), 0);
    AT_DMA(AT_TILE(NT > 1 ? 1 : 0), 1);
    f32x16 o[4];
#pragma unroll
    for (int db = 0; db < 4; ++db)
#pragma unroll
        for (int i = 0; i < 16; ++i) o[db][i] = 0.f;
    float m_ref = -40.f, l_run = 0.f;
    const bool grpB = w >= 4;
#define AT_QK(kb, ks) do { const bf16x8 kf = *(const LAS bf16x8*)(Ks + (kb) * 8192 + (kbase0 ^ (32 * (ks)))); s[kb] = mfma32(kf, qf[ks], s[kb]); } while (0)
#define AT_PV(base, s2, pfrag) do { _Pragma("unroll") for (int db = 0; db < 4; ++db) { const bf16x8 vf = *(const LAS bf16x8*)((base) + db * 4096 + (vbase0 ^ (32 * (s2)))); o[db] = mfma32(vf, pfrag, o[db]); } asm volatile("" ::: "memory"); } while (0)
#define AT_SM1(kb, mxv) do { const unsigned wsh = ((kb) ? (unsigned)(mw >> 32) : (unsigned)mw) >> (4 * hh); mxv = -1e30f; \
            _Pragma("unroll") for (int i = 0; i < 16; ++i) { const bool sel = (wsh & (1u << ((i & 3) + 8 * (i >> 2)))) != 0u; s[kb][i] = sel ? s[kb][i] - m_ref : -1e30f; mxv = fmaxf(mxv, s[kb][i]); } \
            { auto rr = __builtin_amdgcn_permlane32_swap(__float_as_uint(mxv), __float_as_uint(mxv), false, false); mxv = fmaxf(__uint_as_float(rr[0]), __uint_as_float(rr[1])); } } while (0)
#define AT_RESC(kb, mxv) do { if (__any(mxv > 8.0f)) { const float dl = mxv > 8.0f ? mxv : 0.f; m_ref += dl; const float alpha = __builtin_amdgcn_exp2f(-dl); l_run *= alpha; \
            _Pragma("unroll") for (int i = 0; i < 16; ++i) s[kb][i] -= dl; \
            _Pragma("unroll") for (int db = 0; db < 4; ++db) _Pragma("unroll") for (int i = 0; i < 16; ++i) o[db][i] *= alpha; } } while (0)
#define AT_SM2(kb, pa, pb) do { float psum = 0.f; _Pragma("unroll") for (int i = 0; i < 16; ++i) { const float pv = __builtin_amdgcn_exp2f(s[kb][i]); s[kb][i] = pv; psum += pv; } l_run += psum; \
            u32x4 pw; pw.x = cvtpk(s[kb][0], s[kb][1]); pw.y = cvtpk(s[kb][2], s[kb][3]); pw.z = cvtpk(s[kb][4], s[kb][5]); pw.w = cvtpk(s[kb][6], s[kb][7]); pa = __builtin_bit_cast(bf16x8, pw); \
            pw.x = cvtpk(s[kb][8], s[kb][9]); pw.y = cvtpk(s[kb][10], s[kb][11]); pw.z = cvtpk(s[kb][12], s[kb][13]); pw.w = cvtpk(s[kb][14], s[kb][15]); pb = __builtin_bit_cast(bf16x8, pw); } while (0)
#define AT_PSCALE(pf, al) do { u32x4 pq = __builtin_bit_cast(u32x4, pf); _Pragma("unroll") for (int e = 0; e < 4; ++e) { \
            const float lo_ = __builtin_bit_cast(float, pq[e] << 16) * (al), hi_ = __builtin_bit_cast(float, pq[e] & 0xffff0000u) * (al); pq[e] = cvtpk(lo_, hi_); } pf = __builtin_bit_cast(bf16x8, pq); } while (0)
#define AT_HEAD() \
        asm volatile("s_waitcnt vmcnt(5) lgkmcnt(0)\n\ts_barrier" ::: "memory");    \
        const unsigned long long mw = *(const LAS unsigned long long*)(ldsb + ATT_MOFF + (t & 3) * 2048 + w * 256 + r32 * 8); \
        { const int tn = AT_TILE(t + 2 < NT ? t + 2 : NT - 1); AT_DMA(tn, ((t + 2) & 3)); }     \
        const LAS unsigned char* Ks = ldsb + (t & 3) * ATT_STAGE; \
        f32x16 s[2]; float mx0, mx1; \
        _Pragma("unroll") for (int i = 0; i < 16; ++i) { s[0][i] = 0.f; s[1][i] = 0.f; }
    if (!grpB) {
        for (int t = 0; t < NT; ++t) {
            AT_HEAD();
#pragma unroll
            for (int ks = 0; ks < 8; ++ks) AT_QK(0, ks);
            asm volatile("" ::: "memory");
#pragma unroll
            for (int ks = 0; ks < 8; ++ks) AT_QK(1, ks);
            asm volatile("" ::: "memory");
            bf16x8 p0a, p0b, p1a, p1b;
            AT_SM1(0, mx0);
            AT_RESC(0, mx0);
            AT_SM2(0, p0a, p0b);
            AT_PV(Ks, 0, p0a); AT_PV(Ks, 1, p0b);
            AT_SM1(1, mx1);
            AT_RESC(1, mx1);
            AT_SM2(1, p1a, p1b);
            AT_PV(Ks, 2, p1a); AT_PV(Ks, 3, p1b);
        }
    } else {
        bf16x8 p0a = {0, 0, 0, 0, 0, 0, 0, 0}, p0b = p0a, p1a = p0a, p1b = p0a;
        for (int t = 0; t < NT; ++t) {
            AT_HEAD();
            if (t > 0) { const LAS unsigned char* Kp = ldsb + ((t + 3) & 3) * ATT_STAGE; AT_PV(Kp, 0, p0a); AT_PV(Kp, 1, p0b); AT_PV(Kp, 2, p1a); AT_PV(Kp, 3, p1b); }
#pragma unroll
            for (int ks = 0; ks < 8; ++ks) AT_QK(0, ks);
            asm volatile("" ::: "memory");
#pragma unroll
            for (int ks = 0; ks < 8; ++ks) AT_QK(1, ks);
            asm volatile("" ::: "memory");
            AT_SM1(0, mx0);
            AT_RESC(0, mx0);
            AT_SM2(0, p0a, p0b);
            AT_SM1(1, mx1);
            if (__any(mx1 > 8.0f)) { const float al = __builtin_amdgcn_exp2f(-(mx1 > 8.0f ? mx1 : 0.f)); AT_PSCALE(p0a, al); AT_PSCALE(p0b, al); }
            AT_RESC(1, mx1);
            AT_SM2(1, p1a, p1b);
        }
        { const LAS unsigned char* Kp = ldsb + ((NT - 1) & 3) * ATT_STAGE; AT_PV(Kp, 0, p0a); AT_PV(Kp, 1, p0b); AT_PV(Kp, 2, p1a); AT_PV(Kp, 3, p1b); }
    }
#undef AT_HEAD
#undef AT_TILE
#undef AT_QK
#undef AT_PV
#undef AT_SM1
#undef AT_RESC
#undef AT_SM2
#undef AT_PSCALE
#undef AT_DMA
    asm volatile("s_waitcnt vmcnt(0)" ::: "memory");
    float l_tot; { auto rr = __builtin_amdgcn_permlane32_swap(__float_as_uint(l_run), __float_as_uint(l_run), false, false); l_tot = __uint_as_float(rr[0]) + __uint_as_float(rr[1]); }
    const float rl = 1.0f / l_tot;
    bf16_t* orow = (bf16_t*)(P.ws + OFF_O) + qrow * D + h * 128;
#pragma unroll
    for (int db = 0; db < 4; ++db)
#pragma unroll
        for (int i4 = 0; i4 < 4; ++i4) { u32x2 wv; wv.x = cvtpk(o[db][4 * i4] * rl, o[db][4 * i4 + 1] * rl); wv.y = cvtpk(o[db][4 * i4 + 2] * rl, o[db][4 * i4 + 3] * rl);
            *(u32x2*)(orow + 32 * db + 8 * i4 + 4 * hh) = wv; }
}


#define XB_TMO      128
#define XB_XCNT(j)  (256  + 64 * (j))
#define XB_XSUB(j)  (1280 + 64 * (j))
#define XB_XGEN(j)  (2304 + 64 * (j))
#define XB_TOP      3328
#define XB_TOPGEN   3392
#define XCD_BAR_WORDS 3456
#define XB_SPIN_CAP (1u << 18)
__device__ __forceinline__ unsigned xb_ld(unsigned* p)              { return __hip_atomic_load(p, __ATOMIC_RELAXED, __HIP_MEMORY_SCOPE_AGENT); }
__device__ __forceinline__ unsigned xb_add(unsigned* p, unsigned v) { return __hip_atomic_fetch_add(p, v, __ATOMIC_RELAXED, __HIP_MEMORY_SCOPE_AGENT); }
__device__ __forceinline__ unsigned xb_xcc_id() { return (unsigned)__builtin_amdgcn_s_getreg((3 << 11) | 20) & 0xFu; }
#define XB_SPIN(cond, bar) do { unsigned _sp = 0; while (cond) { __builtin_amdgcn_s_sleep(1); \
    if ((++_sp & 255u) == 0u) { if (xb_ld(&(bar)[XB_TMO])) break; if (_sp > XB_SPIN_CAP) { atomicAdd(&(bar)[XB_TMO], 1u); break; } } } } while (0)
struct XcdBarrier { unsigned* bar; unsigned x; volatile LAS unsigned* st; };
__device__ __forceinline__ XcdBarrier xcd_barrier_post(unsigned* bar, volatile LAS unsigned* st) {
    XcdBarrier b; b.bar = bar; b.x = xb_xcc_id(); b.st = st;
    if (threadIdx.x == 0) (void)xb_add(&bar[XB_XCNT(b.x)], 1u);
    return b;
}
__device__ __forceinline__ void xcd_barrier_complete(unsigned* bar, unsigned x, unsigned& nloc, unsigned& nx) {
    const unsigned G = gridDim.x * gridDim.y * gridDim.z;
    unsigned sum, cnt, mine, sp = 0u;
    for (;;) {
        sum = 0u; cnt = 0u; mine = 0u;
#pragma unroll
        for (unsigned j = 0; j < 16; ++j) { const unsigned c = xb_ld(&bar[XB_XCNT(j)]); sum += c; cnt += (c > 0u) ? 1u : 0u; mine = (j == x) ? c : mine; }
        if (sum == G) break;
        __builtin_amdgcn_s_sleep(1);
        if ((++sp & 255u) == 0u) { if (xb_ld(&bar[XB_TMO])) break; if (sp > XB_SPIN_CAP) { atomicAdd(&bar[XB_TMO], 1u); break; } }
    }
    nloc = mine > 0u ? mine : 1u; nx = cnt > 0u ? cnt : 1u;
}
__device__ __forceinline__ void xcd_barrier(const XcdBarrier& b) {
    asm volatile("s_waitcnt vmcnt(0)" ::: "memory");
    __syncthreads();
    if (threadIdx.x == 0) {
        unsigned* bar = b.bar;
        __builtin_amdgcn_s_waitcnt(0);
        unsigned nloc = b.st[0], nx = b.st[1];
        if (nloc == 0u) { xcd_barrier_complete(bar, b.x, nloc, nx); b.st[0] = nloc; b.st[1] = nx; }
        const unsigned old = xb_add(&bar[XB_XSUB(b.x)], 1u);
        const unsigned gen = old / nloc;
        if (old + 1u == (gen + 1u) * nloc) {
            __builtin_amdgcn_fence(__ATOMIC_RELEASE, "agent");
            asm volatile("s_waitcnt vmcnt(0)" ::: "memory");
            (void)xb_add(&bar[XB_TOP], 1u);
        }
        const unsigned want = (gen + 1u) * nx;
        XB_SPIN(xb_ld(&bar[XB_TOP]) < want, bar);
        __builtin_amdgcn_fence(__ATOMIC_ACQUIRE, "agent");
        asm volatile("s_waitcnt vmcnt(0)" ::: "memory");
    }
    __syncthreads();
}
constexpr size_t OFF_STATS = 512 * 1024;
constexpr size_t OFF_BAR = 200 * 1024;
constexpr int LDS_BARST = LDS_BYTES - 64;

__global__ void __launch_bounds__(NTHR, 2) fwd_kernel(Params P) {
    extern __shared__ __attribute__((aligned(16))) unsigned char lds_raw[];
    LAS unsigned char* lds = (LAS unsigned char*)lds_raw;
    cg::grid_group grid = cg::this_grid();
    const int tid = threadIdx.x, lane = tid & 63, wave = tid >> 6; const int G = gridDim.x;
    unsigned char* ws = P.ws;
    const float* MOD = (const float*)(ws + OFF_MOD);
#define MODP(layer, idx) (MOD + ((size_t)(layer) * 2 * 6 + (idx)) * D)
    const int lo = P.ph_lo, hi = P.ph_hi;
    volatile LAS unsigned* xst = (volatile LAS unsigned*)(lds + LDS_BARST);
    if (tid < 2) xst[tid] = 0u;
    __syncthreads();
    XcdBarrier xbar; xbar.bar = (unsigned*)(ws + OFF_BAR); xbar.x = 0; xbar.st = xst;
    if (hi - lo > 1) xbar = xcd_barrier_post((unsigned*)(ws + OFF_BAR), xst);
    if (hi > 1000) grid.sync();
#ifndef PHMASK
#define PHMASK 0x1ffff
#endif
#define IN(k) (((PHMASK >> (k)) & 1) && lo <= (k) && (k) < hi)
#ifndef REPMASK
#define REPMASK 0
#endif
#define REPN(k) ((((REPMASK) >> (k)) & 1) ? 2 : 1)
#define SEAM(k) do { if (IN(k) && IN((k) + 1)) xcd_barrier(xbar); } while (0)

    if (IN(0)) for (int rep_ = 0; rep_ < REPN(0); ++rep_) {
        if (G == 256) { if (blockIdx.x < 128) s5_table_item(P, blockIdx.x, (LAS float*)lds);
                        else { mod_item(P, blockIdx.x - 128, (LAS float*)lds); if (blockIdx.x < 192) mod_item(P, blockIdx.x, (LAS float*)lds); } }
        else for (int it = blockIdx.x; it < 192 + 128; it += G) { if (it < 192) mod_item(P, it, (LAS float*)lds); else s5_table_item(P, it - 192, (LAS float*)lds); }
        __syncthreads();
        LAS float* scr = (LAS float*)(lds + wave * 16384);
        const int gw = blockIdx.x * NW + wave, NGW = G * NW;
        constexpr int I0 = 32 * 64, I1 = 32 * 128, I2 = 32 * 352, I4 = 88 * 64, I6 = 32 * 227, I7 = 32 * 64, IR = 256;
        constexpr int NIT = I0 + I1 + 2 * I2 + 2 * I4 + I6 + I7 + IR;
        for (int it = gw; it < NIT; it += NGW) {
            int r = it; const float* W; bf16_t* WT; int K_, N_, mode;
            if (r < I0) { W = P.s5_in_w; WT = (bf16_t*)(ws + OFF_W_S5IN); K_ = D; N_ = D; mode = 0; }
            else if ((r -= I0) < I1) { W = P.glu_w; WT = (bf16_t*)(ws + OFF_W_GLU); K_ = D; N_ = 2 * D; mode = 1; }
            else if ((r -= I1) < I2) { W = P.ffn_w_in; WT = (bf16_t*)(ws + OFF_W_FIN0); K_ = D; N_ = 2 * DFF; mode = 2; }
            else if ((r -= I2) < I2) { W = P.ffn_w_in + (size_t)D * 2 * DFF; WT = (bf16_t*)(ws + OFF_W_FIN1); K_ = D; N_ = 2 * DFF; mode = 2; }
            else if ((r -= I2) < I4) { W = P.ffn_w_out; WT = (bf16_t*)(ws + OFF_W_FOUT0); K_ = DFF; N_ = D; mode = 0; }
            else if ((r -= I4) < I4) { W = P.ffn_w_out + (size_t)DFF * D; WT = (bf16_t*)(ws + OFF_W_FOUT1); K_ = DFF; N_ = D; mode = 0; }
            else if ((r -= I4) < I6) { W = P.dsa_in_w; WT = (bf16_t*)(ws + OFF_W_DIN); K_ = D; N_ = DSA_IN; mode = 3; }
            else if ((r -= I6) < I7) { W = P.dsa_out_w; WT = (bf16_t*)(ws + OFF_W_DOUT); K_ = D; N_ = D; mode = 0; }
            else { r -= I7; rope_item(P, r, lane); continue; }
            transpose_item(W, K_, N_, WT, mode, scr, r, lane);
        }
        __syncthreads();
    }
    SEAM(0);
#ifdef EXTRA_SYNCS
    for (int e_ = 0; e_ < EXTRA_SYNCS; ++e_) grid.sync();
#endif
    if (IN(1)) for (int rep_ = 0; rep_ < REPN(1); ++rep_) row_pass<0>(P.x, nullptr, nullptr, MODP(0, 1), MODP(0, 0), nullptr, (bf16_t*)(ws + OFF_HB), G);
    SEAM(1);
    if (IN(2)) for (int rep_ = 0; rep_ < REPN(2); ++rep_) { pg8::Gemm g{(const bf16_t*)(ws + OFF_HB), (const bf16_t*)(ws + OFF_W_S5IN), M, D, D}; pg8::StaticOrder S; S.init(M, D, G, blockIdx.x);
        EpiU E{(bf16_t*)(ws + OFF_UG)}; pg8::gemm_phase(lds, g, S, E); }
    SEAM(2);
    if (IN(3)) for (int rep_ = 0; rep_ < REPN(3); ++rep_) { for (int it = blockIdx.x; it < 256; it += G) {
            int g = it >> 1, b = it & 1;
            if (G == 256) { const int x = it & 7, k = it >> 3, j = x + 8 * (k >> 3), sub = k & 7; g = 4 * j + (sub >> 1); b = sub & 1; }
            s5_item(P, g, b, lds); } }
    SEAM(3);
    if (IN(4)) for (int rep_ = 0; rep_ < REPN(4); ++rep_) { pg8::Gemm g{(const bf16_t*)(ws + OFF_G), (const bf16_t*)(ws + OFF_W_GLU), M, 2 * D, D}; pg8::StaticOrder S; S.init(M, 2 * D, G, blockIdx.x);
        EpiGLU E{P.glu_b, P.x, MODP(0, 2), (bf16_t*)(ws + OFF_V)}; pg8::gemm_phase(lds, g, S, E); }
    SEAM(4);
    if (IN(5)) for (int rep_ = 0; rep_ < REPN(5); ++rep_) row_pass<1>((const void*)(ws + OFF_V), P.ln_g, P.ln_b, MODP(0, 4), MODP(0, 3), (float*)(ws + OFF_STATS), (bf16_t*)(ws + OFF_HB), G);
    SEAM(5);
    if (IN(6)) for (int rep_ = 0; rep_ < REPN(6); ++rep_) { pg8::Gemm g{(const bf16_t*)(ws + OFF_HB), (const bf16_t*)(ws + OFF_W_FIN0), M, 2 * DFF, D}; pg8::StaticOrder S; S.init(M, 2 * DFF, G, blockIdx.x);
        EpiSwiGLU E{(bf16_t*)(ws + OFF_ACT)}; pg8::gemm_phase(lds, g, S, E); }
    SEAM(6);
    if (IN(7)) for (int rep_ = 0; rep_ < REPN(7); ++rep_) { pg8::Gemm g{(const bf16_t*)(ws + OFF_ACT), (const bf16_t*)(ws + OFF_W_FOUT0), M, D, DFF}; pg8::StaticOrder S; S.init(M, D, G, blockIdx.x);
        EpiRes E{(const bf16_t*)(ws + OFF_V), (const f32x2*)(ws + OFF_STATS), P.ln_g, P.ln_b, MODP(0, 5), (bf16_t*)(ws + OFF_X)}; pg8::gemm_phase(lds, g, S, E); }
    SEAM(7);
    if (IN(8)) for (int rep_ = 0; rep_ < REPN(8); ++rep_) row_pass<1>((const void*)(ws + OFF_X), P.ln_g + D, P.ln_b + D, MODP(1, 1), MODP(1, 0), (float*)(ws + OFF_STATS), (bf16_t*)(ws + OFF_HB), G);
    SEAM(8);
    if (IN(9)) for (int rep_ = 0; rep_ < REPN(9); ++rep_) { pg8::Gemm g{(const bf16_t*)(ws + OFF_HB), (const bf16_t*)(ws + OFF_W_DIN), M, DSA_NP, D}; pg8::StaticOrder S; S.init(M, DSA_NP, G, blockIdx.x);
        EpiDSA E{(bf16_t*)(ws + OFF_Q), (bf16_t*)(ws + OFF_K), (bf16_t*)(ws + OFF_VT), (bf16_t*)(ws + OFF_QI), (bf16_t*)(ws + OFF_KI), (float*)(ws + OFF_WI),
                 (const f32x2*)(ws + OFF_CSH), (const f32x2*)(ws + OFF_CSI)}; pg8::gemm_phase(lds, g, S, E); }
    SEAM(9);
    if (IN(10)) for (int rep_ = 0; rep_ < REPN(10); ++rep_) { for (int j = blockIdx.x; j < 1024; j += G) { const int b = j >> 9, jj = j & 511; const int blk = jj < 256 ? jj : 767 - jj; indexer_block(P, b, blk, lds); } }
    SEAM(10);
    if (IN(11)) for (int rep_ = 0; rep_ < REPN(11); ++rep_) {
        const int nu = (G == 256) ? 4 : (1024 - (int)blockIdx.x + G - 1) / G;
        for (int u = 0; u < nu; ++u) {
            int bh, qb; bool dsc;
            if (G == 256) { const int x = blockIdx.x & 7, li = blockIdx.x >> 3, gsel = li >> 4, p = li & 15; bh = x * 4 + 2 * (u >> 1) + gsel; dsc = (u & 1) != 0; qb = dsc ? 31 - p : p; }
            else { const int i = blockIdx.x + u * G; bh = i & 31; qb = 31 - (i >> 5); dsc = false; }
            attn_unit(P, bh >> 4, bh & 15, qb, dsc, lds);
        }
    }
    SEAM(11);
    if (IN(12)) for (int rep_ = 0; rep_ < REPN(12); ++rep_) { pg8::Gemm g{(const bf16_t*)(ws + OFF_O), (const bf16_t*)(ws + OFF_W_DOUT), M, D, D}; pg8::StaticOrder S; S.init(M, D, G, blockIdx.x);
        EpiRes E{(const bf16_t*)(ws + OFF_X), (const f32x2*)(ws + OFF_STATS), P.ln_g + D, P.ln_b + D, MODP(1, 2), (bf16_t*)(ws + OFF_V)}; pg8::gemm_phase(lds, g, S, E); }
    SEAM(12);
    if (IN(13)) for (int rep_ = 0; rep_ < REPN(13); ++rep_) row_pass<1>((const void*)(ws + OFF_V), P.ln_g + 2 * D, P.ln_b + 2 * D, MODP(1, 4), MODP(1, 3), (float*)(ws + OFF_STATS), (bf16_t*)(ws + OFF_HB), G);
    SEAM(13);
    if (IN(14)) for (int rep_ = 0; rep_ < REPN(14); ++rep_) { pg8::Gemm g{(const bf16_t*)(ws + OFF_HB), (const bf16_t*)(ws + OFF_W_FIN1), M, 2 * DFF, D}; pg8::StaticOrder S; S.init(M, 2 * DFF, G, blockIdx.x);
        EpiSwiGLU E{(bf16_t*)(ws + OFF_ACT)}; pg8::gemm_phase(lds, g, S, E); }
    SEAM(14);
    if (IN(15)) for (int rep_ = 0; rep_ < REPN(15); ++rep_) { pg8::Gemm g{(const bf16_t*)(ws + OFF_ACT), (const bf16_t*)(ws + OFF_W_FOUT1), M, D, DFF}; pg8::StaticOrder S; S.init(M, D, G, blockIdx.x);
        EpiRes E{(const bf16_t*)(ws + OFF_V), (const f32x2*)(ws + OFF_STATS), P.ln_g + 2 * D, P.ln_b + 2 * D, MODP(1, 5), (bf16_t*)(ws + OFF_X)}; pg8::gemm_phase(lds, g, S, E); }
    SEAM(15);
    if (IN(16)) for (int rep_ = 0; rep_ < REPN(16); ++rep_) row_pass<2>((const void*)(ws + OFF_X), P.ln_g + 3 * D, P.ln_b + 3 * D, nullptr, nullptr, P.out, nullptr, G);
#undef IN
#undef SEAM
#undef MODP
}

#ifndef MK_SPLIT
#define MK_SPLIT 0
#endif
constexpr int NPHASE = 17;

extern "C" void kernel_launch(void* const* d_in, const int* in_sizes, int n_in, void* d_out, int out_size, void* d_ws, size_t ws_size, hipStream_t stream) {
    static int grid = 0;
    if (grid == 0) {
        if (n_in != 22 || out_size != M * D || ws_size < WS_NEED) { fprintf(stderr, "kernel_launch: unexpected shapes (n_in %d out %d ws %zu)\n", n_in, out_size, ws_size); grid = -1; return; }
        int dev = 0, cus = 0, per_cu = 0;
        hipGetDevice(&dev); hipDeviceGetAttribute(&cus, hipDeviceAttributeMultiprocessorCount, dev);
        hipFuncSetAttribute((const void*)fwd_kernel, hipFuncAttributeMaxDynamicSharedMemorySize, LDS_BYTES);
        hipOccupancyMaxActiveBlocksPerMultiprocessor(&per_cu, (const void*)fwd_kernel, NTHR, LDS_BYTES);
        if (per_cu < 1) per_cu = 1;
        grid = cus * per_cu; if (grid > 256) grid = 256;
        (void)hipGetLastError();
    }
    if (grid < 0) return;
    Params p{};
    p.x = (const float*)d_in[0]; p.c = (const float*)d_in[1]; p.pos = (const int*)d_in[2]; p.ada_w = (const float*)d_in[3]; p.ada_b = (const float*)d_in[4];
    p.ln_g = (const float*)d_in[5]; p.ln_b = (const float*)d_in[6]; p.s5_in_w = (const float*)d_in[7]; p.a_re = (const float*)d_in[8]; p.a_im = (const float*)d_in[9];
    p.log_dt = (const float*)d_in[10]; p.b_re = (const float*)d_in[11]; p.b_im = (const float*)d_in[12]; p.c_re = (const float*)d_in[13]; p.c_im = (const float*)d_in[14];
    p.s5_d = (const float*)d_in[15]; p.glu_w = (const float*)d_in[16]; p.glu_b = (const float*)d_in[17]; p.dsa_in_w = (const float*)d_in[18]; p.dsa_out_w = (const float*)d_in[19];
    p.ffn_w_in = (const float*)d_in[20]; p.ffn_w_out = (const float*)d_in[21];
    p.out = (float*)d_out; p.ws = (unsigned char*)d_ws;
#if MK_SPLIT
    for (int ph = 0; ph < NPHASE; ++ph) { p.ph_lo = ph; p.ph_hi = ph + 1; hipLaunchKernelGGL(fwd_kernel, dim3(grid), dim3(NTHR), LDS_BYTES, stream, p); }
#else
    p.ph_lo = 0; p.ph_hi = NPHASE;
    (void)hipMemsetAsync((char*)d_ws + OFF_BAR, 0, 16384, stream);
    void* args[] = {&p};
    hipError_t e = hipLaunchCooperativeKernel((const void*)fwd_kernel, dim3(grid), dim3(NTHR), args, LDS_BYTES, stream);
    if (e != hipSuccess) fprintf(stderr, "cooperative launch failed: %s (grid %d)\n", hipGetErrorString(e), grid);
#endif
}
```
